# Optimizing an MI355X kernel written in HIP

```python
import math
import jax, jax.numpy as jnp
from jax import lax
import numpy as np

D_MODEL = 1024
BATCH = 2
SEQ = 8192
DEPTH = 1

M_HEADS = 4
M_HEAD_DIM = 256
M_WIDTH = M_HEADS * M_HEAD_DIM
M_CHUNK = 64
CONV_WIDTH = 4
N_HEADS = 8
N_KV_GROUPS = 2
N_HPG = N_HEADS // N_KV_GROUPS
N_HEAD_DIM = 64
N_WIDTH = N_HEADS * N_HEAD_DIM
N_KV_WIDTH = N_KV_GROUPS * N_HEAD_DIM
CMP_BLOCK = 32
CMP_STRIDE = 16
CMP_HIDDEN = 128
SEL_BLOCK = 64
SEL_TOPK = 16
WINDOW = 512
Q_BLOCK = 128
ROPE_THETA = 500000.0
ROPE_DIM = N_HEAD_DIM // 4
NORM_EPS = 1e-6
NEG = -1e30
FORCE = 1e9

IN_SPLITS = (
    ("m_q", M_WIDTH), ("m_k", M_WIDTH), ("m_v", M_WIDTH), ("m_o", M_WIDTH), ("m_z", M_WIDTH),
    ("m_i", M_HEADS), ("m_f", M_HEADS),
    ("n_q", N_WIDTH), ("n_kc", N_KV_WIDTH), ("n_vc", N_KV_WIDTH),
    ("n_ks", N_KV_WIDTH), ("n_vs", N_KV_WIDTH), ("n_kw", N_KV_WIDTH), ("n_vw", N_KV_WIDTH),
    ("n_g", 3 * N_HEADS), ("n_z", N_WIDTH),
    ("g_a", D_MODEL), ("g_b", D_MODEL),
)
IN_WIDTH = sum(w for _, w in IN_SPLITS)

kernel_name = "hybrid_mlstm_nsa_gated_block"


def _rmsnorm(x, g):
    xf = x.astype(jnp.float32)
    r = lax.rsqrt(jnp.mean(xf * xf, axis=-1, keepdims=True) + NORM_EPS)
    return (xf * r * g).astype(x.dtype)


def _split_in(u):
    names = [n for n, _ in IN_SPLITS]
    cuts = np.cumsum([w for _, w in IN_SPLITS])[:-1].tolist()
    return dict(zip(names, jnp.split(u, cuts, axis=-1)))


def _causal_dwconv(u, w, b):
    K = w.shape[0]
    T = u.shape[1]
    up = jnp.pad(u, ((0, 0), (K - 1, 0), (0, 0)))
    return b + sum(up[:, j:j + T] * w[j] for j in range(K))


def _partial_rope(u, pos):
    half = ROPE_DIM // 2
    inv = jnp.power(jnp.float32(ROPE_THETA), -jnp.arange(half, dtype=jnp.float32) * (2.0 / ROPE_DIM))
    ang = pos.astype(jnp.float32)[..., None] * inv
    cos = jnp.cos(ang)[:, :, None, :]
    sin = jnp.sin(ang)[:, :, None, :]
    u1 = u[..., :half]
    u2 = u[..., half:ROPE_DIM]
    r1 = u1 * cos - u2 * sin
    r2 = u2 * cos + u1 * sin
    return jnp.concatenate([r1.astype(u.dtype), r2.astype(u.dtype), u[..., ROPE_DIM:]], axis=-1)


def _mlstm(q, k, v, i_pre, f_pre):
    B, T, H, d = q.shape
    L = M_CHUNK
    NC = T // L
    k = k * (d ** -0.5)

    def to_chunks(a):
        a = a.reshape((B, NC, L, H) + a.shape[3:])
        return jnp.moveaxis(a, (1, 3), (0, 2))

    log_f = jax.nn.log_sigmoid(f_pre)
    log_i = i_pre
    causal = jnp.tril(jnp.ones((L, L), dtype=bool))

    def step(carry, xs):
        C, n, m = carry
        qc, kc, vc, li, lf = xs
        a = jnp.cumsum(lf, axis=-1)
        A = a[..., -1]
        logD = a[..., :, None] - a[..., None, :] + li[..., None, :]
        logD = jnp.where(causal, logD, -jnp.inf)
        inter = a + m[..., None]
        m_t = jnp.maximum(inter, jnp.max(logD, axis=-1))
        w_inter = jnp.exp(inter - m_t)
        s = jnp.einsum('bhld,bhsd->bhls', qc, kc) * jnp.exp(logD - m_t[..., None])
        num = w_inter[..., None] * jnp.einsum('bhld,bhde->bhle', qc, C) + jnp.einsum('bhls,bhse->bhle', s, vc)
        den = w_inter * jnp.einsum('bhld,bhd->bhl', qc, n) + jnp.sum(s, axis=-1)
        h = num / jnp.maximum(jnp.abs(den), jnp.exp(-m_t))[..., None]
        logw = A[..., None] - a + li
        m_new = jnp.maximum(A + m, jnp.max(logw, axis=-1))
        wk = jnp.exp(logw - m_new[..., None])
        decay = jnp.exp(A + m - m_new)
        C_new = decay[..., None, None] * C + jnp.einsum('bhs,bhsd,bhse->bhde', wk, kc, vc)
        n_new = decay[..., None] * n + jnp.einsum('bhs,bhsd->bhd', wk, kc)
        return (C_new, n_new, m_new), h

    init = (jnp.zeros((B, H, d, d), jnp.float32), jnp.zeros((B, H, d), jnp.float32),
            jnp.zeros((B, H), jnp.float32))
    xs = (to_chunks(q), to_chunks(k), to_chunks(v), to_chunks(log_i), to_chunks(log_f))
    _, hs = lax.scan(step, init, xs)
    hs = jnp.moveaxis(hs, (0, 2), (1, 3))
    return hs.reshape(B, T, H, d)


def _head_layernorm(h, g):
    B, T = h.shape[0], h.shape[1]
    mu = jnp.mean(h, axis=-1, keepdims=True)
    var = jnp.mean(jnp.square(h - mu), axis=-1, keepdims=True)
    hn = (h - mu) * lax.rsqrt(var + NORM_EPS)
    return hn.reshape(B, T, -1) * g


def _compress(kv, pos_emb, w1, w2):
    B, T, G, dk = kv.shape
    n_cmp = (T - CMP_BLOCK) // CMP_STRIDE + 1
    idx = jnp.arange(n_cmp)[:, None] * CMP_STRIDE + jnp.arange(CMP_BLOCK)[None, :]
    blocks = kv[:, idx] + pos_emb[None, None, :, None, :]
    blocks = jnp.moveaxis(blocks, 3, 1).reshape(B, G, n_cmp, CMP_BLOCK * dk)
    return jax.nn.gelu(blocks @ w1) @ w2


def _nsa(q_raw, q_rope, kc, vc, ks, vs, kw, vw, gates):
    B, G, h, T, dk = q_raw.shape
    n_cmp = kc.shape[2]
    n_sel = T // SEL_BLOCK
    n_top = min(SEL_TOPK, n_sel)
    scale = dk ** -0.5
    cmp_end = jnp.arange(n_cmp) * CMP_STRIDE + (CMP_BLOCK - 1)
    ci = jnp.arange(n_cmp)[:, None] * CMP_STRIDE
    sj = jnp.arange(n_sel)[None, :] * SEL_BLOCK
    overlap = ((ci < sj + SEL_BLOCK) & (ci + CMP_BLOCK > sj)).astype(jnp.float32)
    ks_blocks = ks.reshape(B, G, n_sel, SEL_BLOCK, dk)
    vs_blocks = vs.reshape(B, G, n_sel, SEL_BLOCK, dk)
    kw_pad = jnp.pad(kw, ((0, 0), (0, 0), (WINDOW, 0), (0, 0)))
    vw_pad = jnp.pad(vw, ((0, 0), (0, 0), (WINDOW, 0), (0, 0)))
    bi = jnp.arange(B)[:, None, None, None]
    gi = jnp.arange(G)[None, :, None, None]
    blk = jnp.arange(n_sel)

    def block(i):
        t0 = i * Q_BLOCK
        tq = t0 + jnp.arange(Q_BLOCK)
        qr = lax.dynamic_slice_in_dim(q_raw, t0, Q_BLOCK, axis=3)
        qp = lax.dynamic_slice_in_dim(q_rope, t0, Q_BLOCK, axis=3)
        g = lax.dynamic_slice_in_dim(gates, t0, Q_BLOCK, axis=3)
        s_c = jnp.einsum('bghqd,bgnd->bghqn', qr, kc).astype(jnp.float32) * scale
        m_c = cmp_end[None, :] <= tq[:, None]
        p_c = jax.nn.softmax(jnp.where(m_c, s_c, NEG), axis=-1) * m_c
        o_c = jnp.einsum('bghqn,bgnd->bghqd', p_c.astype(vc.dtype), vc)
        imp = jnp.einsum('bghqn,ns->bgqs', p_c, overlap)
        cur = tq // SEL_BLOCK
        forced = (blk[None, :] == 0) | (blk[None, :] == cur[:, None]) | (blk[None, :] == cur[:, None] - 1)
        valid = blk[None, :] * SEL_BLOCK <= tq[:, None]
        score = jnp.where(forced, FORCE, jnp.where(valid, imp, -1.0))
        _, idx = lax.top_k(score, n_top)
        kg = ks_blocks[bi, gi, idx]
        vg = vs_blocks[bi, gi, idx]
        kpos = idx[..., None] * SEL_BLOCK + jnp.arange(SEL_BLOCK)
        m_s = kpos <= tq[:, None, None]
        s_s = jnp.einsum('bghqd,bgqnsd->bghqns', qp, kg).astype(jnp.float32) * scale
        s_s = jnp.where(m_s[:, :, None], s_s, NEG).reshape(B, G, h, Q_BLOCK, n_top * SEL_BLOCK)
        p_s = jax.nn.softmax(s_s, axis=-1).reshape(B, G, h, Q_BLOCK, n_top, SEL_BLOCK)
        o_s = jnp.einsum('bghqns,bgqnsd->bghqd', p_s.astype(vg.dtype), vg)
        kwb = lax.dynamic_slice_in_dim(kw_pad, t0, Q_BLOCK + WINDOW, axis=2)
        vwb = lax.dynamic_slice_in_dim(vw_pad, t0, Q_BLOCK + WINDOW, axis=2)
        wpos = t0 - WINDOW + jnp.arange(Q_BLOCK + WINDOW)
        diff = tq[:, None] - wpos[None, :]
        m_w = (diff >= 0) & (diff < WINDOW) & (wpos[None, :] >= 0)
        s_w = jnp.einsum('bghqd,bgkd->bghqk', qp, kwb).astype(jnp.float32) * scale
        p_w = jax.nn.softmax(jnp.where(m_w, s_w, NEG), axis=-1)
        o_w = jnp.einsum('bghqk,bgkd->bghqd', p_w.astype(vwb.dtype), vwb)
        return g[..., 0:1] * o_c + g[..., 1:2] * o_s + g[..., 2:3] * o_w

    out = lax.map(block, jnp.arange(T // Q_BLOCK))
    out = jnp.moveaxis(out, 0, 3).reshape(B, G, h, T, dk)
    return out.transpose(0, 3, 1, 2, 4).reshape(B, T, G * h * dk)


def setup_inputs(seed: int = 0) -> dict:
    key = jax.random.key(seed)
    ks = jax.random.split(key, 24)
    f32 = jnp.float32

    def nrm(k, shape, scale):
        return jax.random.normal(k, shape, f32) * scale

    x = nrm(ks[0], (BATCH, SEQ, D_MODEL), 1.0)
    positions = jnp.tile(jnp.arange(SEQ, dtype=jnp.int32)[None, :], (BATCH, 1))
    norm_g = 1.0 + nrm(ks[1], (DEPTH, D_MODEL), 0.05)
    w_in = nrm(ks[2], (DEPTH, D_MODEL, IN_WIDTH), D_MODEL ** -0.5)
    conv_q_w = nrm(ks[3], (DEPTH, CONV_WIDTH, M_WIDTH), CONV_WIDTH ** -0.5)
    conv_q_b = nrm(ks[4], (DEPTH, M_WIDTH), 0.02)
    conv_k_w = nrm(ks[5], (DEPTH, CONV_WIDTH, M_WIDTH), CONV_WIDTH ** -0.5)
    conv_k_b = nrm(ks[6], (DEPTH, M_WIDTH), 0.02)
    b_igate = nrm(ks[7], (DEPTH, M_HEADS), 0.1)
    b_fgate = jnp.linspace(3.0, 6.0, M_HEADS, dtype=f32)[None, :] + nrm(ks[8], (DEPTH, M_HEADS), 0.1)
    mh_norm_g = 1.0 + nrm(ks[9], (DEPTH, M_WIDTH), 0.05)
    cmp_pos_k = nrm(ks[10], (DEPTH, CMP_BLOCK, N_HEAD_DIM), 0.1)
    cmp_w1_k = nrm(ks[11], (DEPTH, CMP_BLOCK * N_HEAD_DIM, CMP_HIDDEN), (CMP_BLOCK * N_HEAD_DIM) ** -0.5)
    cmp_w2_k = nrm(ks[12], (DEPTH, CMP_HIDDEN, N_HEAD_DIM), CMP_HIDDEN ** -0.5)
    cmp_pos_v = nrm(ks[13], (DEPTH, CMP_BLOCK, N_HEAD_DIM), 0.1)
    cmp_w1_v = nrm(ks[14], (DEPTH, CMP_BLOCK * N_HEAD_DIM, CMP_HIDDEN), (CMP_BLOCK * N_HEAD_DIM) ** -0.5)
    cmp_w2_v = nrm(ks[15], (DEPTH, CMP_HIDDEN, N_HEAD_DIM), CMP_HIDDEN ** -0.5)
    b_nsa_gate = nrm(ks[16], (DEPTH, 3 * N_HEADS), 0.1)
    w_branch_a = nrm(ks[17], (DEPTH, M_WIDTH, D_MODEL), M_WIDTH ** -0.5)
    w_branch_b = nrm(ks[18], (DEPTH, N_WIDTH, D_MODEL), N_WIDTH ** -0.5)
    w_out = nrm(ks[19], (DEPTH, D_MODEL, D_MODEL), D_MODEL ** -0.5)
    final_norm_g = 1.0 + nrm(ks[20], (D_MODEL,), 0.05)
    return {"x": x, "positions": positions, "norm_g": norm_g, "w_in": w_in,
            "conv_q_w": conv_q_w, "conv_q_b": conv_q_b, "conv_k_w": conv_k_w, "conv_k_b": conv_k_b,
            "b_igate": b_igate, "b_fgate": b_fgate, "mh_norm_g": mh_norm_g,
            "cmp_pos_k": cmp_pos_k, "cmp_w1_k": cmp_w1_k, "cmp_w2_k": cmp_w2_k,
            "cmp_pos_v": cmp_pos_v, "cmp_w1_v": cmp_w1_v, "cmp_w2_v": cmp_w2_v,
            "b_nsa_gate": b_nsa_gate, "w_branch_a": w_branch_a, "w_branch_b": w_branch_b,
            "w_out": w_out, "final_norm_g": final_norm_g}


def reference(x, positions, norm_g, w_in, conv_q_w, conv_q_b, conv_k_w, conv_k_b, b_igate, b_fgate,
              mh_norm_g, cmp_pos_k, cmp_w1_k, cmp_w2_k, cmp_pos_v, cmp_w1_v, cmp_w2_v, b_nsa_gate,
              w_branch_a, w_branch_b, w_out, final_norm_g):
    B, T, _ = x.shape
    f32 = jnp.float32
    for l in range(DEPTH):
        hN = _rmsnorm(x, norm_g[l])
        p = _split_in(hN @ w_in[l])
        mq = jax.nn.silu(_causal_dwconv(p["m_q"], conv_q_w[l], conv_q_b[l]))
        mk = jax.nn.silu(_causal_dwconv(p["m_k"], conv_k_w[l], conv_k_b[l]))
        mh = _mlstm(mq.reshape(B, T, M_HEADS, M_HEAD_DIM).astype(f32),
                    mk.reshape(B, T, M_HEADS, M_HEAD_DIM).astype(f32),
                    p["m_v"].reshape(B, T, M_HEADS, M_HEAD_DIM).astype(f32),
                    (p["m_i"] + b_igate[l]).astype(f32),
                    (p["m_f"] + b_fgate[l]).astype(f32))
        mh = _head_layernorm(mh, mh_norm_g[l]).astype(x.dtype)
        ya = jax.nn.sigmoid(p["m_o"]) * mh * jax.nn.silu(p["m_z"])
        nq = p["n_q"].reshape(B, T, N_HEADS, N_HEAD_DIM)
        q_raw = nq.reshape(B, T, N_KV_GROUPS, N_HPG, N_HEAD_DIM).transpose(0, 2, 3, 1, 4)
        q_rope = _partial_rope(nq, positions).reshape(B, T, N_KV_GROUPS, N_HPG, N_HEAD_DIM).transpose(0, 2, 3, 1, 4)

        def kvh(a):
            return a.reshape(B, T, N_KV_GROUPS, N_HEAD_DIM)

        kc = _compress(kvh(p["n_kc"]), cmp_pos_k[l], cmp_w1_k[l], cmp_w2_k[l])
        vc = _compress(kvh(p["n_vc"]), cmp_pos_v[l], cmp_w1_v[l], cmp_w2_v[l])
        ks = _partial_rope(kvh(p["n_ks"]), positions).transpose(0, 2, 1, 3)
        vs = kvh(p["n_vs"]).transpose(0, 2, 1, 3)
        kw = _partial_rope(kvh(p["n_kw"]), positions).transpose(0, 2, 1, 3)
        vw = kvh(p["n_vw"]).transpose(0, 2, 1, 3)
        gates = jax.nn.sigmoid(p["n_g"] + b_nsa_gate[l]).reshape(B, T, N_KV_GROUPS, N_HPG, 3).transpose(0, 2, 3, 1, 4)
        yn = _nsa(q_raw, q_rope, kc, vc, ks, vs, kw, vw, gates)
        yb = yn * jax.nn.silu(p["n_z"])
        merged = (jax.nn.sigmoid(p["g_a"]) * (ya @ w_branch_a[l])
                  + jax.nn.sigmoid(p["g_b"]) * (yb @ w_branch_b[l]))
        x = x + merged @ w_out[l]
    return _rmsnorm(x, final_norm_g)
```

```cpp
#include <hip/hip_runtime.h>
#include <hip/hip_cooperative_groups.h>
#include <cstdio>
#include <cstdint>
namespace cg = cooperative_groups;
namespace pg8 {
#define PG8_LAS __attribute__((address_space(3)))
typedef unsigned short bf16_t;
typedef short bf16x8 __attribute__((ext_vector_type(8)));
typedef float f32x4 __attribute__((ext_vector_type(4)));
typedef unsigned u32x4 __attribute__((ext_vector_type(4)));
constexpr int BM = 256, BK = 64, HALF = 128, HTB = HALF * BK * 2  , STAGE_BYTES = 8 * HTB, NXCD = 8, WGM = 8;

__host__ __device__ __forceinline__ int lds_byte(int r, int c) { const int st = (r >> 4) * 2 + (c >> 5), rr = r & 15, cc = c & 31, ob = rr * 64 + cc * 2; return st * 1024 + (ob ^ (((ob >> 9) & 1) << 5)); }
__host__ __device__ __forceinline__ void stage_rc(int b, int& R, int& C) { const int st = b / 1024, sb = b % 1024, swz = sb ^ (((sb >> 9) & 1) << 5); R = (st >> 1) * 16 + swz / 64; C = (st & 1) * 32 + (swz % 64) / 2; }
__host__ __device__ __forceinline__ int perm32(int rho) { const int n = rho >> 4, i = rho & 15; return 8 * (i >> 2) + 4 * n + (i & 3); }

struct Unit { int pm, pn; };
struct Gemm { const bf16_t* A; const bf16_t* Bt; int M, N, K; };

struct StaticOrder {
    int nM, nN, nwg, G, c;
    __host__ __device__ void init(int M, int N, int G_, int c_) { nM = M / BM; nN = N / BM; nwg = nM * nN; G = G_; c = c_; }
    __host__ __device__ bool next(int i, Unit& u) const {
        const long L = (long)i * G + c; if (L >= nwg) return false;
        int wgid = (int)L; { const int q = nwg / NXCD, r = nwg % NXCD, xcd = wgid % NXCD, off = wgid / NXCD; wgid = (xcd < r ? xcd * (q + 1) : r * (q + 1) + (xcd - r) * q) + off; }
        const int nig = WGM * nN, gid = wgid / nig, fm = gid * WGM, gsz = (nM - fm) < WGM ? (nM - fm) : WGM;
        u.pm = fm + ((wgid % nig) % gsz); u.pn = (wgid % nig) / gsz; return true;
    }
    __device__ __forceinline__ void a_ready(const Unit&) const {}
    __device__ __forceinline__ void done(const Unit&) const {}
};

__device__ __forceinline__ unsigned cvt_pk_bf16(float lo, float hi) { unsigned r; asm volatile("v_cvt_pk_bf16_f32 %0, %1, %2" : "=v"(r) : "v"(lo), "v"(hi)); return r; }
template <class Epi, class Sched, bool ALIGN_EPI = false, bool SP2 = false>
__device__ __forceinline__ void gemm_phase(PG8_LAS unsigned char* lds, const Gemm g, const Sched& S, const Epi& E) {
    const int tid = threadIdx.x, wid = __builtin_amdgcn_readfirstlane(tid >> 6), lane = tid & 63, wr = wid >> 2, wc = wid & 3, fr = lane & 15, fq = lane >> 4;
    const int K = g.K, nt = K / BK;
    unsigned voffA[2], voffB[2];
#pragma unroll
    for (int i = 0; i < 2; ++i) { int R, C; stage_rc(tid * 16 + i * 8192, R, C); const int Rb = Epi::PERM ? ((R & ~31) + perm32(R & 31)) : R;
        voffA[i] = (unsigned)(R * K + C) * 2u; voffB[i] = (unsigned)(Rb * K + C) * 2u; }
    const size_t kstep = (size_t)(BK * 2);
    const size_t hstep = (size_t)HALF * K * 2;
    const size_t tstep = 2 * hstep;
    const unsigned ldsw = (unsigned)wid * 1024u;
    const int aoff = lds_byte(wr * 64 + fr, fq * 8), boff = lds_byte(wc * 32 + fr, fq * 8);
#define PG8_SA(b, h) (((b) * 2 + (h)) * HTB)
#define PG8_SB(b, h) ((4 + (b) * 2 + (h)) * HTB)
#define PG8_STAGE(bufoff, gbase, voff) do { _Pragma("unroll") for (int _i = 0; _i < 2; ++_i) \
        __builtin_amdgcn_global_load_lds((const unsigned*)((const char*)(gbase) + (voff)[_i]), (PG8_LAS unsigned*)(lds + (bufoff) + ldsw + _i * 8192), 16, 0, 0); } while (0)
#define PG8_LDA(dst, b, h) do { _Pragma("unroll") for (int m = 0; m < 4; ++m) _Pragma("unroll") for (int k = 0; k < 2; ++k) dst[m][k] = *(const PG8_LAS bf16x8*)(lds + PG8_SA(b, h) + aoff + m * 2048 + k * 1024); } while (0)
#define PG8_LDB(dst, b, h) do { _Pragma("unroll") for (int n = 0; n < 2; ++n) _Pragma("unroll") for (int k = 0; k < 2; ++k) dst[n][k] = *(const PG8_LAS bf16x8*)(lds + PG8_SB(b, h) + boff + n * 2048 + k * 1024); } while (0)
#define PG8_MMA(ai, bj, At, Bt) do { __builtin_amdgcn_s_setprio(1); _Pragma("unroll") for (int m = 0; m < 4; ++m) _Pragma("unroll") for (int n = 0; n < 2; ++n) _Pragma("unroll") for (int k = 0; k < 2; ++k) \
        acc[ai][bj][m][n] = __builtin_amdgcn_mfma_f32_16x16x32_bf16(Bt[n][k], At[m][k], acc[ai][bj][m][n], 0, 0, 0); __builtin_amdgcn_s_setprio(0); } while (0)
#define PG8_WAIT_V(n) asm volatile("s_waitcnt vmcnt(" #n ")" ::: "memory")
#define PG8_WAIT_L(n) asm volatile("s_waitcnt lgkmcnt(" #n ")" ::: "memory")
#define PG8_BAR __builtin_amdgcn_s_barrier()
#define PG8_SCHED __builtin_amdgcn_sched_barrier(0)
    Unit cur, nxt; int ui = 0;
    if (!S.next(0, cur)) return;
    f32x4 acc[2][2][4][2];
#pragma unroll
    for (int a = 0; a < 2; ++a)
#pragma unroll
        for (int b = 0; b < 2; ++b)
#pragma unroll
            for (int m = 0; m < 4; ++m)
#pragma unroll
                for (int n = 0; n < 2; ++n) acc[a][b][m][n] = (f32x4){0.f, 0.f, 0.f, 0.f};
    bf16x8 At[4][2], B0[2][2], B1[2][2];
    const char* cA = (const char*)g.A + (size_t)cur.pm * tstep; const char* cB = (const char*)g.Bt + (size_t)cur.pn * tstep;
    S.a_ready(cur);
    if constexpr (SP2) {
        PG8_STAGE(PG8_SB(0, 0), cB, voffB); PG8_STAGE(PG8_SB(0, 1), cB + hstep, voffB); PG8_STAGE(PG8_SA(0, 0), cA, voffA); PG8_STAGE(PG8_SA(0, 1), cA + hstep, voffA);
        if (wr == 1) PG8_BAR;
        PG8_WAIT_V(2); PG8_BAR;
        PG8_STAGE(PG8_SB(1, 0), cB + kstep, voffB); PG8_STAGE(PG8_SA(1, 0), cA + kstep, voffA); PG8_STAGE(PG8_SB(1, 1), cB + hstep + kstep, voffB);
        PG8_WAIT_V(6); PG8_BAR;
    } else {
        PG8_STAGE(PG8_SB(0, 0), cB, voffB); PG8_STAGE(PG8_SA(0, 0), cA, voffA); PG8_STAGE(PG8_SB(0, 1), cB + hstep, voffB); PG8_STAGE(PG8_SA(0, 1), cA + hstep, voffA);
        if (wr == 1) PG8_BAR;
        PG8_WAIT_V(4); PG8_BAR;
        PG8_STAGE(PG8_SB(1, 0), cB + kstep, voffB); PG8_STAGE(PG8_SA(1, 0), cA + kstep, voffA); PG8_STAGE(PG8_SB(1, 1), cB + hstep + kstep, voffB);
        PG8_WAIT_V(6); PG8_BAR;
    }
    for (;;) {
        const bool has_next = S.next(ui + 1, nxt);
        const char* nA = has_next ? (const char*)g.A + (size_t)nxt.pm * tstep : cA; const char* nB = has_next ? (const char*)g.Bt + (size_t)nxt.pn * tstep : cB;
        for (int t = 0; t < nt; t += 2) {
            const bool last = (t == nt - 2);
            const char* a1 = cA + (size_t)(t + 1) * kstep;
            const char* a2 = last ? nA : cA + (size_t)(t + 2) * kstep; const char* b2 = last ? nB : cB + (size_t)(t + 2) * kstep;
            const char* a3 = a2 + kstep; const char* b3 = b2 + kstep;
            if (last && has_next) S.a_ready(nxt);
            if constexpr (SP2) {
            PG8_LDB(B0, 0, 0); PG8_LDB(B1, 0, 1); PG8_SCHED; PG8_LDA(At, 0, 0); PG8_STAGE(PG8_SA(1, 1), a1 + hstep, voffA);
            PG8_WAIT_V(8); PG8_WAIT_L(0); PG8_BAR; PG8_MMA(0, 0, At, B0); PG8_MMA(0, 1, At, B1); PG8_BAR; PG8_SCHED;
            PG8_LDA(At, 0, 1); PG8_STAGE(PG8_SB(0, 0), b2, voffB); PG8_STAGE(PG8_SB(0, 1), b2 + hstep, voffB); PG8_STAGE(PG8_SA(0, 0), a2, voffA);
            PG8_WAIT_V(8); PG8_WAIT_L(0); PG8_BAR; PG8_MMA(1, 0, At, B0); PG8_MMA(1, 1, At, B1); PG8_BAR; PG8_SCHED;
            PG8_LDB(B0, 1, 0); PG8_LDB(B1, 1, 1); PG8_SCHED; PG8_LDA(At, 1, 0); PG8_STAGE(PG8_SA(0, 1), a2 + hstep, voffA);
            PG8_WAIT_V(8); PG8_WAIT_L(0); PG8_BAR; PG8_MMA(0, 0, At, B0); PG8_MMA(0, 1, At, B1); PG8_BAR; PG8_SCHED;
            PG8_LDA(At, 1, 1); PG8_STAGE(PG8_SB(1, 0), b3, voffB); PG8_STAGE(PG8_SB(1, 1), b3 + hstep, voffB); PG8_STAGE(PG8_SA(1, 0), a3, voffA);
            PG8_WAIT_V(8); PG8_WAIT_L(0); PG8_BAR; PG8_MMA(1, 0, At, B0); PG8_MMA(1, 1, At, B1); PG8_BAR; PG8_SCHED;
            } else {
            PG8_LDB(B0, 0, 0); PG8_SCHED; PG8_LDA(At, 0, 0); PG8_STAGE(PG8_SA(1, 1), a1 + hstep, voffA);
            PG8_WAIT_L(8); PG8_BAR; PG8_WAIT_L(0); PG8_MMA(0, 0, At, B0); PG8_BAR; PG8_SCHED;
            PG8_LDB(B1, 0, 1); PG8_STAGE(PG8_SB(0, 0), b2, voffB);
            PG8_BAR; PG8_WAIT_L(0); PG8_MMA(0, 1, At, B1); PG8_BAR;
            PG8_LDA(At, 0, 1); PG8_STAGE(PG8_SA(0, 0), a2, voffA);
            PG8_BAR; PG8_WAIT_L(0); PG8_MMA(1, 0, At, B0); PG8_BAR; PG8_SCHED;
            PG8_STAGE(PG8_SB(0, 1), b2 + hstep, voffB);
            PG8_WAIT_V(6); PG8_BAR; PG8_MMA(1, 1, At, B1); PG8_BAR;
            PG8_LDB(B0, 1, 0); PG8_SCHED; PG8_LDA(At, 1, 0); PG8_STAGE(PG8_SA(0, 1), a2 + hstep, voffA);
            PG8_WAIT_L(8); PG8_BAR; PG8_WAIT_L(0); PG8_MMA(0, 0, At, B0); PG8_BAR; PG8_SCHED;
            PG8_LDB(B1, 1, 1); PG8_STAGE(PG8_SB(1, 0), b3, voffB);
            PG8_BAR; PG8_WAIT_L(0); PG8_MMA(0, 1, At, B1); PG8_BAR;
            PG8_LDA(At, 1, 1); PG8_STAGE(PG8_SA(1, 0), a3, voffA);
            PG8_BAR; PG8_WAIT_L(0); PG8_MMA(1, 0, At, B0); PG8_BAR; PG8_SCHED;
            PG8_STAGE(PG8_SB(1, 1), b3 + hstep, voffB);
            PG8_WAIT_V(6); PG8_BAR; PG8_MMA(1, 1, At, B1); PG8_BAR;
            }
        }
        if constexpr (ALIGN_EPI) { if (wr == 0) PG8_BAR; }
        if constexpr (!Epi::AFTER_DRAIN) { E(acc, cur, wr, wc, fr, fq); S.done(cur); }
        if (!has_next) break;
#pragma unroll
        for (int a = 0; a < 2; ++a)
#pragma unroll
            for (int b = 0; b < 2; ++b)
#pragma unroll
                for (int m = 0; m < 4; ++m)
#pragma unroll
                    for (int n = 0; n < 2; ++n) acc[a][b][m][n] = (f32x4){0.f, 0.f, 0.f, 0.f};
        cur = nxt; cA = nA; cB = nB; ++ui;
        if constexpr (ALIGN_EPI) { if (wr == 1) PG8_BAR; }
    }
    PG8_WAIT_V(0);
    if constexpr (!ALIGN_EPI) { if (wr == 0) PG8_BAR; }
    PG8_BAR;
    if constexpr (Epi::AFTER_DRAIN) { E.fused(acc, cur, wr, wc, fr, fq, lds, wid, lane); S.done(cur); }
#undef PG8_SA
#undef PG8_SB
#undef PG8_STAGE
#undef PG8_LDA
#undef PG8_LDB
#undef PG8_MMA
#undef PG8_WAIT_V
#undef PG8_WAIT_L
#undef PG8_BAR
#undef PG8_SCHED
}
}

#define LAS __attribute__((address_space(3)))
using pg8::bf16_t; using pg8::bf16x8; using pg8::f32x4; using pg8::u32x4;
typedef short bf16x4 __attribute__((ext_vector_type(4)));
typedef unsigned u32x2 __attribute__((ext_vector_type(2)));
constexpr int BATCH = 2, T = 8192, D = 1024, M = BATCH * T;
constexpr int N1 = 4608, N2 = 4608, INW = 8992;
constexpr float EPS = 1e-6f;
constexpr int NTHR = 512, NWAVES = 8;
constexpr int LDS_BYTES = 147456;
constexpr int MLSTM_E = 32, NBM = 8 * (256 / MLSTM_E);

constexpr size_t MiB = 1u << 20, KiB = 1u << 10;
constexpr size_t OFF_ROWSS = 0, OFF_LCF = 64 * KiB, OFF_MT = 320 * KiB, OFF_LI = 576 * KiB, OFF_RS = 832 * KiB, OFF_DEC = 1088 * KiB, OFF_CTR = 1096 * KiB, OFF_BAR = 1104 * KiB  , OFF_ROPE = 2 * MiB, OFF_RSS16 = 3 * MiB;
constexpr size_t WS_KN = 4 * MiB, WS_NPREV = 5 * MiB, WS_KC = 6 * MiB, WS_VCT = 6 * MiB + 256 * KiB, WS_W1KT = 6 * MiB + 512 * KiB, WS_W1VT = 7 * MiB,
                 WS_W2KT = 7 * MiB + 512 * KiB, WS_W2VT = 7 * MiB + 528 * KiB, WS_GATES = 8 * MiB, WS_WA = 10 * MiB, WS_WO = 12 * MiB, WS_WB = 14 * MiB,
                 WS_WIN = 16 * MiB, WS_SP = 16 * MiB  , WS_XN = 34 * MiB, WS_MQ = 66 * MiB, WS_MK = 98 * MiB, WS_MV = 130 * MiB,
                 WS_NQ = 162 * MiB, WS_KVRM = 178 * MiB, WS_VT = 194 * MiB, WS_NUM = 202 * MiB, WS_YN = 234 * MiB, WS_END = 250 * MiB;

struct Prm {
    const float* x; const int* pos; const float *norm_g, *w_in, *cqw, *cqb, *ckw, *ckb, *big, *bfg, *mhg, *cpk, *cw1k, *cw2k, *cpv, *cw1v, *cw2v, *bng, *wa, *wb, *wo, *fng;
    float* out; unsigned char* ws;
    int ph_lo, ph_hi, coop, pad;
};

__device__ __forceinline__ unsigned f2bf(float f) { unsigned u = __builtin_bit_cast(unsigned, f); return (u + 0x7fffu + ((u >> 16) & 1u)) >> 16; }
__device__ __forceinline__ float bflo(unsigned w) { return __builtin_bit_cast(float, w << 16); }
__device__ __forceinline__ float bfhi(unsigned w) { return __builtin_bit_cast(float, w & 0xffff0000u); }
typedef __bf16 bf16v2_t __attribute__((ext_vector_type(2)));
typedef float f32v2_t __attribute__((ext_vector_type(2)));
__device__ __forceinline__ unsigned pk2(float lo, float hi) { const f32v2_t f = {lo, hi}; const bf16v2_t r = __builtin_convertvector(f, bf16v2_t); return __builtin_bit_cast(unsigned, r); }
__device__ __forceinline__ float sigmoidf_(float v) { return 1.f / (1.f + __expf(-v)); }
__device__ __forceinline__ float siluf_(float v) { return v / (1.f + __expf(-v)); }
#define DPP_I(v, ctrl) __builtin_amdgcn_update_dpp(0, (int)(v), (ctrl), 0xF, 0xF, true)
__device__ __forceinline__ float dpp_f(float v, const int ctrl_sel) {
    const int i = __builtin_bit_cast(int, v);
    const int r = ctrl_sel == 0 ? DPP_I(i, 0xB1) : (ctrl_sel == 1 ? DPP_I(i, 0x4E) : (ctrl_sel == 2 ? DPP_I(i, 0x124) : DPP_I(i, 0x128)));
    return __builtin_bit_cast(float, r);
}
__device__ __forceinline__ float wave_sum(float v) {
    v += dpp_f(v, 0); v += dpp_f(v, 1); v += dpp_f(v, 2); v += dpp_f(v, 3);
    v += __shfl_xor(v, 16); v += __shfl_xor(v, 32);
    return v;
}
__device__ __forceinline__ float wave_max(float v) {
#pragma unroll
    for (int o = 1; o < 64; o <<= 1) v = fmaxf(v, __shfl_xor(v, o));
    return v;
}
#define LDS_WAIT() asm volatile("s_waitcnt lgkmcnt(0)" ::: "memory")
__device__ __forceinline__ f32x4 mfma16(bf16x8 a, bf16x8 b, f32x4 c) { return __builtin_amdgcn_mfma_f32_16x16x32_bf16(a, b, c, 0, 0, 0); }
__device__ __forceinline__ void unpack8(u32x4 w, float (&f)[8]) {
    f[0] = bflo(w.x); f[1] = bfhi(w.x); f[2] = bflo(w.y); f[3] = bfhi(w.y); f[4] = bflo(w.z); f[5] = bfhi(w.z); f[6] = bflo(w.w); f[7] = bfhi(w.w);
}
__device__ __forceinline__ u32x4 pack8(const float (&f)[8]) { u32x4 w; w.x = pk2(f[0], f[1]); w.y = pk2(f[2], f[3]); w.z = pk2(f[4], f[5]); w.w = pk2(f[6], f[7]); return w; }

__device__ __forceinline__ unsigned row16_max_u32(unsigned v) {
    unsigned t;
    t = (unsigned)DPP_I(v, 0xB1); v = v > t ? v : t;
    t = (unsigned)DPP_I(v, 0x4E); v = v > t ? v : t;
    t = (unsigned)DPP_I(v, 0x124); v = v > t ? v : t;
    t = (unsigned)DPP_I(v, 0x128); v = v > t ? v : t;
    return v;
}
typedef unsigned long long u64_t;
__device__ __forceinline__ unsigned pk4_fp8(float a, float b, float c, float d) { int w = __builtin_amdgcn_cvt_pk_fp8_f32(a, b, 0, false); w = __builtin_amdgcn_cvt_pk_fp8_f32(c, d, w, true); return (unsigned)w; }
__device__ __forceinline__ u32x2 pk8_fp8(const float (&f)[8]) { u32x2 r; r.x = pk4_fp8(f[0], f[1], f[2], f[3]); r.y = pk4_fp8(f[4], f[5], f[6], f[7]); return r; }
__device__ __forceinline__ f32x4 mfma8(unsigned alo, unsigned ahi, u32x2 b, f32x4 c) {
    const u32x2 a = {alo, ahi};
    return __builtin_amdgcn_mfma_f32_16x16x32_fp8_fp8(__builtin_bit_cast(long, a), __builtin_bit_cast(long, b), c, 0, 0, 0);
}
struct EpiP1 {
    static constexpr bool PERM = true, AFTER_DRAIN = false;
    bf16_t* mqkv; bf16_t* nq; bf16_t* kvrm; bf16_t* vT; float* gates;
    __device__ __forceinline__ void operator()(const f32x4 (&acc)[2][2][4][2], const pg8::Unit& u, int wr, int wc, int fr, int fq) const {
        const int pn = u.pn; const int row0 = u.pm * 256 + wr * 64 + fr;
#pragma unroll
        for (int ai = 0; ai < 2; ++ai)
#pragma unroll
            for (int m = 0; m < 4; ++m) {
                const int row = row0 + ai * 128 + m * 16; const int b = row >> 13, t = row & (T - 1);
#pragma unroll
                for (int bj = 0; bj < 2; ++bj) {
                    const f32x4 v0 = acc[ai][bj][m][0], v1 = acc[ai][bj][m][1];
                    const int c = pn * 256 + bj * 128 + wc * 32 + 8 * fq;
                    if (pn == 17) {
                        const int cc = c - 4352;
                        if (cc < 32) { float* gp = gates + (size_t)row * 32 + cc; *(f32x4*)gp = v0; *(f32x4*)(gp + 4) = v1; }
                    } else {
                        u32x4 w; w.x = pk2(v0[0], v0[1]); w.y = pk2(v0[2], v0[3]); w.z = pk2(v1[0], v1[1]); w.w = pk2(v1[2], v1[3]);
                        bf16_t* dp;
                        if (pn < 12) { const int arr = pn >> 2; dp = mqkv + (size_t)arr * ((size_t)M * 1024) + (size_t)row * 1024 + (c - arr * 1024); }
                        else if (pn < 14) { dp = nq + (size_t)row * 512 + (c - 3072); }
                        else { const int cc = c - pn * 256; const int seg = cc >> 7, g = (cc >> 6) & 1, d = cc & 63; const int arr = (pn - 14) * 2 + seg;
                               dp = kvrm + (size_t)arr * (4 * T * 64) + (size_t)((b * 2 + g) * T + t) * 64 + d; }
                        *(u32x4*)dp = w;
                    }
                }
            }
    }
};
struct EpiP2 {
    static constexpr bool PERM = true, AFTER_DRAIN = false;
    bf16_t* hn; bf16_t* yn; bf16_t* sga; bf16_t* sgb;
    __device__ __forceinline__ void operator()(const f32x4 (&acc)[2][2][4][2], const pg8::Unit& u, int wr, int wc, int fr, int fq) const {
        const int pn = u.pn; const int row0 = u.pm * 256 + wr * 64 + fr;
#pragma unroll
        for (int ai = 0; ai < 2; ++ai)
#pragma unroll
            for (int m = 0; m < 4; ++m) {
                const int row = row0 + ai * 128 + m * 16;
#pragma unroll
                for (int bj = 0; bj < 2; ++bj) {
                    const f32x4 v0 = acc[ai][bj][m][0], v1 = acc[ai][bj][m][1];
                    const int c = pn * 256 + bj * 128 + wc * 32 + 8 * fq;
                    if (pn < 8) {
                        const int ch = (c >> 3) * 4;
                        bf16_t* hp = hn + (size_t)row * 1024 + ch; const u32x2 hw = *(const u32x2*)hp;
                        const float h0 = bflo(hw.x), h1 = bfhi(hw.x), h2 = bflo(hw.y), h3 = bfhi(hw.y);
                        u32x2 o; o.x = pk2(sigmoidf_(v0[0]) * siluf_(v1[0]) * h0, sigmoidf_(v0[1]) * siluf_(v1[1]) * h1);
                        o.y = pk2(sigmoidf_(v0[2]) * siluf_(v1[2]) * h2, sigmoidf_(v0[3]) * siluf_(v1[3]) * h3);
                        *(u32x2*)hp = o;
                    } else if (pn < 10) {
                        bf16_t* yp = yn + (size_t)row * 512 + (c - 2048); const u32x4 yw = *(const u32x4*)yp; float y[8]; unpack8(yw, y);
                        u32x4 o; o.x = pk2(y[0] * siluf_(v0[0]), y[1] * siluf_(v0[1])); o.y = pk2(y[2] * siluf_(v0[2]), y[3] * siluf_(v0[3]));
                        o.z = pk2(y[4] * siluf_(v1[0]), y[5] * siluf_(v1[1])); o.w = pk2(y[6] * siluf_(v1[2]), y[7] * siluf_(v1[3]));
                        *(u32x4*)yp = o;
                    } else {
                        bf16_t* dp = (pn < 14) ? sga + (size_t)row * 1024 + (c - 2560) : sgb + (size_t)row * 1024 + (c - 3584);
                        u32x4 o; o.x = pk2(sigmoidf_(v0[0]), sigmoidf_(v0[1])); o.y = pk2(sigmoidf_(v0[2]), sigmoidf_(v0[3]));
                        o.z = pk2(sigmoidf_(v1[0]), sigmoidf_(v1[1])); o.w = pk2(sigmoidf_(v1[2]), sigmoidf_(v1[3]));
                        *(u32x4*)dp = o;
                    }
                }
            }
    }
};
struct EpiE1 {
    static constexpr bool PERM = true, AFTER_DRAIN = false;
    const bf16_t* sga; bf16_t* tmp;
    __device__ __forceinline__ void operator()(const f32x4 (&acc)[2][2][4][2], const pg8::Unit& u, int wr, int wc, int fr, int fq) const {
        const int row0 = u.pm * 256 + wr * 64 + fr;
#pragma unroll
        for (int ai = 0; ai < 2; ++ai)
#pragma unroll
            for (int m = 0; m < 4; ++m) {
                const int row = row0 + ai * 128 + m * 16;
#pragma unroll
                for (int bj = 0; bj < 2; ++bj) {
                    const f32x4 v0 = acc[ai][bj][m][0], v1 = acc[ai][bj][m][1];
                    const int c = u.pn * 256 + bj * 128 + wc * 32 + 8 * fq;
                    float s[8]; unpack8(*(const u32x4*)(sga + (size_t)row * 1024 + c), s);
                    u32x4 o; o.x = pk2(v0[0] * s[0], v0[1] * s[1]); o.y = pk2(v0[2] * s[2], v0[3] * s[3]); o.z = pk2(v1[0] * s[4], v1[1] * s[5]); o.w = pk2(v1[2] * s[6], v1[3] * s[7]);
                    *(u32x4*)(tmp + (size_t)row * 1024 + c) = o;
                }
            }
    }
};
struct EpiE2 {
    static constexpr bool PERM = true, AFTER_DRAIN = false;
    const bf16_t* sgb; const bf16_t* tmp; bf16_t* mg;
    __device__ __forceinline__ void operator()(const f32x4 (&acc)[2][2][4][2], const pg8::Unit& u, int wr, int wc, int fr, int fq) const {
        const int row0 = u.pm * 256 + wr * 64 + fr;
#pragma unroll
        for (int ai = 0; ai < 2; ++ai)
#pragma unroll
            for (int m = 0; m < 4; ++m) {
                const int row = row0 + ai * 128 + m * 16;
#pragma unroll
                for (int bj = 0; bj < 2; ++bj) {
                    const f32x4 v0 = acc[ai][bj][m][0], v1 = acc[ai][bj][m][1];
                    const int c = u.pn * 256 + bj * 128 + wc * 32 + 8 * fq;
                    float s[8]; unpack8(*(const u32x4*)(sgb + (size_t)row * 1024 + c), s);
                    float t[8]; unpack8(*(const u32x4*)(tmp + (size_t)row * 1024 + c), t);
                    u32x4 o; o.x = pk2(t[0] + v0[0] * s[0], t[1] + v0[1] * s[1]); o.y = pk2(t[2] + v0[2] * s[2], t[3] + v0[3] * s[3]);
                    o.z = pk2(t[4] + v1[0] * s[4], t[5] + v1[1] * s[5]); o.w = pk2(t[6] + v1[2] * s[6], t[7] + v1[3] * s[7]);
                    *(u32x4*)(mg + (size_t)row * 1024 + c) = o;
                }
            }
    }
};
struct EpiF {
    static constexpr bool PERM = true, AFTER_DRAIN = false;
    const float* x; float* out; float* rowss;
    __device__ __forceinline__ void operator()(const f32x4 (&acc)[2][2][4][2], const pg8::Unit& u, int wr, int wc, int fr, int fq) const {
        const int row0 = u.pm * 256 + wr * 64 + fr;
#pragma unroll
        for (int ai = 0; ai < 2; ++ai)
#pragma unroll
            for (int m = 0; m < 4; ++m) {
                const int row = row0 + ai * 128 + m * 16; float ss = 0.f;
#pragma unroll
                for (int bj = 0; bj < 2; ++bj) {
                    const int c = u.pn * 256 + bj * 128 + wc * 32 + 8 * fq;
                    const float* xp = x + (size_t)row * 1024 + c; float* op = out + (size_t)row * 1024 + c;
                    f32x4 a = *(const f32x4*)xp + acc[ai][bj][m][0], b = *(const f32x4*)(xp + 4) + acc[ai][bj][m][1];
                    *(f32x4*)op = a; *(f32x4*)(op + 4) = b;
                    ss += (a[0] * a[0] + a[1] * a[1]) + (a[2] * a[2] + a[3] * a[3]) + (b[0] * b[0] + b[1] * b[1]) + (b[2] * b[2] + b[3] * b[3]);
                }
                ss += __shfl_xor(ss, 16); ss += __shfl_xor(ss, 32);
                if (fq == 0) rowss[(size_t)row * 16 + u.pn * 4 + wc] = ss;
            }
    }
};

struct EpiFN {
    static constexpr bool PERM = true, AFTER_DRAIN = true;
    const float* x; float* out; const float* fng; float* slots; unsigned* cnt;
    __device__ __forceinline__ void fused(f32x4 (&acc)[2][2][4][2], const pg8::Unit& u, int wr, int wc, int fr, int fq, LAS unsigned char* lds, int wid, int lane) const {
        LAS float* P = (LAS float*)lds;
        LAS float* S = (LAS float*)(lds + 4096);
        const int tid = wid * 64 + lane;
#pragma unroll
        for (int ai = 0; ai < 2; ++ai)
#pragma unroll
            for (int m = 0; m < 4; ++m) {
                const int rl = ai * 128 + wr * 64 + m * 16 + fr; const int row = u.pm * 256 + rl; float ss = 0.f;
#pragma unroll
                for (int bj = 0; bj < 2; ++bj) {
                    const int c = u.pn * 256 + bj * 128 + wc * 32 + 8 * fq; const float* xp = x + (size_t)row * 1024 + c;
                    const f32x4 a = *(const f32x4*)xp + acc[ai][bj][m][0], b = *(const f32x4*)(xp + 4) + acc[ai][bj][m][1];
                    acc[ai][bj][m][0] = a; acc[ai][bj][m][1] = b;
                    ss += (a[0] * a[0] + a[1] * a[1]) + (a[2] * a[2] + a[3] * a[3]) + (b[0] * b[0] + b[1] * b[1]) + (b[2] * b[2] + b[3] * b[3]);
                }
                ss += __shfl_xor(ss, 16); ss += __shfl_xor(ss, 32);
                if (fq == 0) P[rl * 4 + wc] = ss;
            }
        __syncthreads();
        if (tid < 256) { const float t = (P[tid * 4] + P[tid * 4 + 1]) + (P[tid * 4 + 2] + P[tid * 4 + 3]);
            __hip_atomic_store(slots + (size_t)(u.pm * 256 + tid) * 4 + u.pn, t, __ATOMIC_RELAXED, __HIP_MEMORY_SCOPE_AGENT); }
        asm volatile("s_waitcnt vmcnt(0)" ::: "memory");
        __syncthreads();
        if (tid == 0) {
            __hip_atomic_fetch_add(cnt + u.pm, 1u, __ATOMIC_RELEASE, __HIP_MEMORY_SCOPE_AGENT);
            unsigned sp = 0;
            while (__hip_atomic_load(cnt + u.pm, __ATOMIC_ACQUIRE, __HIP_MEMORY_SCOPE_AGENT) < 4u) { __builtin_amdgcn_s_sleep(2); if (++sp > (1u << 22)) break; }
        }
        __syncthreads();
        if (tid < 256) { const float* sl = slots + (size_t)(u.pm * 256 + tid) * 4; float t = 0.f;
#pragma unroll
            for (int k = 0; k < 4; ++k) t += __hip_atomic_load(sl + k, __ATOMIC_RELAXED, __HIP_MEMORY_SCOPE_AGENT);
            S[tid] = 1.f / sqrtf(t * (1.f / 1024.f) + EPS); }
        __syncthreads();
#pragma unroll
        for (int ai = 0; ai < 2; ++ai)
#pragma unroll
            for (int m = 0; m < 4; ++m) {
                const int rl = ai * 128 + wr * 64 + m * 16 + fr; const int row = u.pm * 256 + rl; const float r = S[rl];
#pragma unroll
                for (int bj = 0; bj < 2; ++bj) {
                    const int c = u.pn * 256 + bj * 128 + wc * 32 + 8 * fq; float* op = out + (size_t)row * 1024 + c;
                    const f32x4 g0 = *(const f32x4*)(fng + c), g1 = *(const f32x4*)(fng + c + 4);
                    *(f32x4*)op = acc[ai][bj][m][0] * r * g0; *(f32x4*)(op + 4) = acc[ai][bj][m][1] * r * g1;
                }
            }
    }
};

__device__ __forceinline__ int win_dest(int n) {
    if (n < 3072) return n;
    if (n < 4096) { const int c = n - 3072; return 4608 + 8 * (c >> 2) + (c & 3); }
    if (n < 5120) { const int c = n - 4096; return 4608 + 8 * (c >> 2) + 4 + (c & 3); }
    if (n < 5124) return 4352 + (n - 5120);
    if (n < 5128) return 4356 + (n - 5124);
    if (n < 5640) return 3072 + (n - 5128);
    if (n < 5768) return 3584 + (n - 5640);
    if (n < 5896) return 3712 + (n - 5768);
    if (n < 6024) return 3840 + (n - 5896);
    if (n < 6152) return 4096 + (n - 6024);
    if (n < 6280) return 3968 + (n - 6152);
    if (n < 6408) return 4224 + (n - 6280);
    if (n < 6432) return 4360 + (n - 6408);
    if (n < 6944) return 4608 + 2048 + (n - 6432);
    if (n < 7968) return 4608 + 2560 + (n - 6944);
    return 4608 + 3584 + (n - 7968);
}
template <bool MAP>
__device__ __forceinline__ void transpose_item(const float* W, int K, int N, bf16_t* WT, LAS float* scr, int item, int lane) {
    const int nblk = N / 32, kb = item / nblk, nb = item % nblk, k0 = 64 * kb, n0 = 32 * nb;
#pragma unroll 8
    for (int i = 0; i < 32; ++i) { const int kk = 2 * i + (lane >> 5); scr[kk * 33 + (lane & 31)] = W[(size_t)(k0 + kk) * N + n0 + (lane & 31)]; }
    LDS_WAIT();
    const int c = lane & 7;
#pragma unroll
    for (int j = 0; j < 4; ++j) { const int n = (lane >> 3) + 8 * j; const LAS float* s = scr + (8 * c) * 33 + n;
        u32x4 o; o.x = pk2(s[0 * 33], s[1 * 33]); o.y = pk2(s[2 * 33], s[3 * 33]); o.z = pk2(s[4 * 33], s[5 * 33]); o.w = pk2(s[6 * 33], s[7 * 33]);
        const int row = MAP ? win_dest(n0 + n) : (n0 + n);
        *(u32x4*)(WT + (size_t)row * K + k0 + 8 * c) = o; }
    LDS_WAIT();
}
__device__ __forceinline__ void phaseA(const Prm& p, LAS unsigned char* L, int G) {
    const int tid = threadIdx.x, lane = tid & 63, wave = tid >> 6;
    const int gw = blockIdx.x * NWAVES + wave, NGW = G * NWAVES, gtid = blockIdx.x * NTHR + tid, NT = G * NTHR;
    unsigned char* ws = p.ws;
    LAS float* scr = (LAS float*)(L + wave * 16384);
    constexpr int NB_E = 137, I_WIN = 16 * NB_E, I_W1 = 32 * 4, I_W2 = 2 * 2;
    constexpr int NITEMS = I_WIN + 2 * I_W1 + 2 * I_W2;
    for (int it = gw; it < NITEMS; it += NGW) {
        int r = it;
        if (r < I_WIN) { const int kb = r / NB_E, ib = r % NB_E, nb = ib < 96 ? ib : ib + 64; transpose_item<true>(p.w_in, 1024, INW, (bf16_t*)(ws + WS_WIN), scr, kb * 281 + nb, lane); continue; } r -= I_WIN;
        if (r < I_W1) { transpose_item<false>(p.cw1k, 2048, 128, (bf16_t*)(ws + WS_W1KT), scr, r, lane); continue; } r -= I_W1;
        if (r < I_W1) { transpose_item<false>(p.cw1v, 2048, 128, (bf16_t*)(ws + WS_W1VT), scr, r, lane); continue; } r -= I_W1;
        if (r < I_W2) { transpose_item<false>(p.cw2k, 128, 64, (bf16_t*)(ws + WS_W2KT), scr, r, lane); continue; } r -= I_W2;
        transpose_item<false>(p.cw2v, 128, 64, (bf16_t*)(ws + WS_W2VT), scr, r, lane);
    }
    {
        u32x4* z = (u32x4*)(ws + WS_WIN + (size_t)4384 * 2048);
        for (int i = gtid; i < 224 * 128; i += NT) z[i] = (u32x4){0u, 0u, 0u, 0u};
    }
    bf16_t* XN = (bf16_t*)(ws + WS_XN);
    for (int m0 = gw; m0 < M; m0 += 4 * NGW) {
        f32x4 v[4][4]; float ss[4];
#pragma unroll
        for (int q = 0; q < 4; ++q) { const int m = m0 + q * NGW < M ? m0 + q * NGW : m0; const f32x4* xr = (const f32x4*)(p.x + (size_t)m * D) + lane;
#pragma unroll
            for (int j = 0; j < 4; ++j) v[q][j] = xr[64 * j]; }
#pragma unroll
        for (int q = 0; q < 4; ++q) { float s_ = 0.f;
#pragma unroll
            for (int j = 0; j < 4; ++j) s_ += (v[q][j][0] * v[q][j][0] + v[q][j][1] * v[q][j][1]) + (v[q][j][2] * v[q][j][2] + v[q][j][3] * v[q][j][3]);
            ss[q] = s_; }
#pragma unroll
        for (int q = 0; q < 4; ++q) ss[q] = wave_sum(ss[q]);
#pragma unroll
        for (int q = 0; q < 4; ++q) { const int m = m0 + q * NGW; if (m < M) {
            const float r = 1.f / sqrtf(ss[q] * (1.f / D) + EPS); const f32x4* gr = (const f32x4*)p.norm_g + lane;
            u32x2* o8 = (u32x2*)(XN + (size_t)m * D) + lane;
#pragma unroll
            for (int j = 0; j < 4; ++j) { const f32x4 g = gr[64 * j]; u32x2 o; o.x = pk2(v[q][j][0] * r * g[0], v[q][j][1] * r * g[1]); o.y = pk2(v[q][j][2] * r * g[2], v[q][j][3] * r * g[3]); o8[64 * j] = o; } } }
    }
    if (blockIdx.x == 0 && tid < 64) ((unsigned*)(ws + OFF_CTR))[tid] = 0u;
    {
        float* tab = (float*)(ws + OFF_ROPE);
        for (int i = gtid; i < M * 8; i += NT) { const int bt = i >> 3, k = i & 7; const float inv = powf(500000.0f, -(float)k * 0.125f);
            const float ang = (float)p.pos[bt] * inv; tab[bt * 16 + k] = cosf(ang); tab[bt * 16 + 8 + k] = sinf(ang); }
    }
}

__device__ __forceinline__ void deferred_weights(const Prm& p, LAS unsigned char* L, int G) {
    const int tid = threadIdx.x, lane = tid & 63, wave = tid >> 6;
    const int half = G / 2; if ((int)blockIdx.x < half) return;
    const int gw = ((int)blockIdx.x - half) * NWAVES + wave, NGW = (G - half) * NWAVES;
    unsigned char* ws = p.ws;
    LAS float* scr = (LAS float*)(L + wave * 16384);
    constexpr int NB_D = 144, I_WIN = 16 * NB_D, I_A = 16 * 32, I_B = 8 * 32, I_O = 16 * 32;
    constexpr int NITEMS = I_WIN + I_A + I_B + I_O;
    for (int it = gw; it < NITEMS; it += NGW) {
        int r = it;
        if (r < I_WIN) { const int kb = r / NB_D, ib = r % NB_D, nb = ib < 64 ? 96 + ib : 201 + (ib - 64); transpose_item<true>(p.w_in, 1024, INW, (bf16_t*)(ws + WS_WIN), scr, kb * 281 + nb, lane); continue; } r -= I_WIN;
        if (r < I_A) { transpose_item<false>(p.wa, 1024, 1024, (bf16_t*)(ws + WS_WA), scr, r, lane); continue; } r -= I_A;
        if (r < I_B) { transpose_item<false>(p.wb, 512, 1024, (bf16_t*)(ws + WS_WB), scr, r, lane); continue; } r -= I_B;
        transpose_item<false>(p.wo, 1024, 1024, (bf16_t*)(ws + WS_WO), scr, r, lane);
    }
}

__device__ __forceinline__ void phaseC1(const Prm& p, LAS unsigned char* L, int G) {
    const int tid = threadIdx.x, lane = tid & 63, wave = tid >> 6, fr = lane & 15, fq = lane >> 4;
    const int gw = blockIdx.x * NWAVES + wave, gtid = blockIdx.x * NTHR + tid, NT = G * NTHR;
    unsigned char* ws = p.ws;
    const float* gates = (const float*)(ws + WS_GATES);
    if (blockIdx.x < 8) {
        const int bh = blockIdx.x, b = bh >> 2, h = bh & 3;
        float* lcf = (float*)(ws + OFF_LCF) + bh * T; float* mtv = (float*)(ws + OFF_MT) + bh * T; float* liv = (float*)(ws + OFF_LI) + bh * T;
        LAS float* red = (LAS float*)L;
        const float bfv = p.bfg[h], biv = p.big[h];
        float cf[16], li[16]; float run = 0.f;
#pragma unroll
        for (int k = 0; k < 16; ++k) { const float* gp = gates + (size_t)(b * T + tid * 16 + k) * 32; const float fp = gp[4 + h] + bfv; li[k] = gp[h] + biv;
            run += fminf(fp, 0.f) - log1pf(expf(-fabsf(fp))); cf[k] = run; }
        float inc = run;
#pragma unroll
        for (int o = 1; o < 64; o <<= 1) { const float v = __shfl_up(inc, o); if (lane >= o) inc += v; }
        if (lane == 63) red[wave] = inc;
        __syncthreads();
        float base = inc - run;
        for (int w = 0; w < wave; ++w) base += red[w];
        float pm[16]; float tm = -INFINITY;
#pragma unroll
        for (int k = 0; k < 16; ++k) { cf[k] += base; tm = fmaxf(tm, li[k] - cf[k]); pm[k] = tm; }
        float incm = tm;
#pragma unroll
        for (int o = 1; o < 64; o <<= 1) { const float v = __shfl_up(incm, o); if (lane >= o) incm = fmaxf(incm, v); }
        if (lane == 63) red[8 + wave] = incm;
        float exm = __shfl_up(incm, 1); if (lane == 0) exm = -INFINITY;
        __syncthreads();
        float R0 = fmaxf(0.f, exm);
        for (int w = 0; w < wave; ++w) R0 = fmaxf(R0, red[8 + w]);
#pragma unroll
        for (int k = 0; k < 16; ++k) { const int t = tid * 16 + k; const float R = fmaxf(R0, pm[k]); lcf[t] = cf[k]; mtv[t] = cf[k] + R; liv[t] = li[k]; }
        __syncthreads();
    }
    {
        LAS bf16_t* H = (LAS bf16_t*)L;
        for (int u = blockIdx.x; u < 256; u += G) {
            const int which = u >> 7, bg = (u >> 5) & 3, it = u & 31;
            const bf16_t* src = (const bf16_t*)(ws + WS_KVRM) + (size_t)which * (4 * T * 64) + (size_t)bg * T * 64;
            const float* pos = which ? p.cpv : p.cpk;
            const bf16_t* w1T = (const bf16_t*)(ws + (which ? WS_W1VT : WS_W1KT)); const bf16_t* w2T = (const bf16_t*)(ws + (which ? WS_W2VT : WS_W2KT));
            const int irow = it * 16 + fr, ic = irow < 511 ? irow : 510;
            const bf16_t* ab = src + (size_t)ic * 1024 + wave * 256; const float* pw = pos + wave * 256; const bf16_t* bb = w1T + (size_t)fr * 2048 + wave * 256;
            f32x4 acc[8];
#pragma unroll
            for (int nt = 0; nt < 8; ++nt) acc[nt] = (f32x4){0.f, 0.f, 0.f, 0.f};
#pragma unroll 2
            for (int ks = 0; ks < 8; ++ks) {
                const int k = ks * 32 + fq * 8;
                float a[8]; unpack8(*(const u32x4*)(ab + k), a);
                const f32x4 p0 = *(const f32x4*)(pw + k), p1 = *(const f32x4*)(pw + k + 4);
                a[0] += p0[0]; a[1] += p0[1]; a[2] += p0[2]; a[3] += p0[3]; a[4] += p1[0]; a[5] += p1[1]; a[6] += p1[2]; a[7] += p1[3];
                const bf16x8 af = __builtin_bit_cast(bf16x8, pack8(a));
#pragma unroll
                for (int nt = 0; nt < 8; ++nt) acc[nt] = mfma16(af, *(const bf16x8*)(bb + (size_t)nt * 16 * 2048 + k), acc[nt]);
            }
            LAS float* Pp = (LAS float*)(L + 8192);
#pragma unroll
            for (int nt = 0; nt < 8; ++nt)
#pragma unroll
                for (int j = 0; j < 4; ++j) Pp[wave * 2048 + (fq * 4 + j) * 128 + nt * 16 + fr] = acc[nt][j];
            __syncthreads();
            {   const int idx = tid * 4; f32x4 sum = *(const LAS f32x4*)(Pp + idx);
#pragma unroll
                for (int w = 1; w < 8; ++w) sum += *(const LAS f32x4*)(Pp + w * 2048 + idx);
                const int i = idx >> 7, n = idx & 127;
#pragma unroll
                for (int j = 0; j < 4; ++j) { const float v = sum[j]; const float gl = 0.5f * v * (1.f + tanhf(0.7978845608028654f * (v + 0.044715f * v * v * v)));
                    H[i * 136 + n + j] = (bf16_t)f2bf(gl); } }
            __syncthreads();
            if (wave < 4) {
                f32x4 a2 = {0.f, 0.f, 0.f, 0.f};
#pragma unroll
                for (int ks = 0; ks < 4; ++ks)
                    a2 = mfma16(*(const LAS bf16x8*)(H + fr * 136 + ks * 32 + fq * 8), *(const bf16x8*)(w2T + (size_t)(wave * 16 + fr) * 128 + ks * 32 + fq * 8), a2);
                const int i0 = it * 16 + fq * 4, d = wave * 16 + fr;
                const int tile = it >> 2, kt = it & 3;
                if (which == 0) { bf16_t* kc = (bf16_t*)(ws + WS_KC) + (size_t)bg * 512 * 64 + tile * 4096;
#pragma unroll
                    for (int j = 0; j < 4; ++j) kc[((kt * 2 + (d >> 5)) * 64 + ((d >> 3) & 3) * 16 + fq * 4 + j) * 8 + (d & 7)] = (i0 + j < 511) ? (bf16_t)f2bf(a2[j]) : (bf16_t)0;
                } else { bf16_t* vc = (bf16_t*)(ws + WS_VCT) + (size_t)bg * 512 * 64 + tile * 4096;
                    u32x2 o; o.x = pk2(a2[0], a2[1]); o.y = pk2(a2[2], (i0 + 3 < 511) ? a2[3] : 0.f);
                    *(u32x2*)(vc + (((kt >> 1) * 4 + wave) * 64 + fq * 16 + fr) * 8 + (kt & 1) * 4) = o; }
            }
            __syncthreads();
        }
    }
    {
        const float* tab = (const float*)(ws + OFF_ROPE);
        LAS bf16_t* tl = (LAS bf16_t*)(L + wave * 16384);
        const int NGW = G * NWAVES;
        for (int item = gw; item < 4 * 4 * 128; item += NGW) {
            const int tile = item & 127, bg = (item >> 7) & 3, arr = 2 + (item >> 9);
            bf16_t* tp = (bf16_t*)(ws + WS_KVRM) + (size_t)arr * (4 * T * 64) + (size_t)(bg * T + tile * 64) * 64;
            if (arr < 4) {
                u32x4 f[8];
#pragma unroll
                for (int kt = 0; kt < 4; ++kt)
#pragma unroll
                    for (int ks = 0; ks < 2; ++ks) f[kt * 2 + ks] = *(const u32x4*)(tp + (kt * 16 + fr) * 64 + ks * 32 + fq * 8);
#pragma unroll
                for (int kt = 0; kt < 4; ++kt) {
                    u32x4 q0 = f[kt * 2];
                    u32x4 ot; ot.x = __shfl_xor(q0.x, 16); ot.y = __shfl_xor(q0.y, 16); ot.z = __shfl_xor(q0.z, 16); ot.w = __shfl_xor(q0.w, 16);
                    if (fq < 2) {
                        const float* tb = tab + (size_t)((bg >> 1) * T + tile * 64 + kt * 16 + fr) * 16; float mine[8], oth[8], r[8]; unpack8(q0, mine); unpack8(ot, oth);
                        const float sg = fq == 0 ? -1.f : 1.f;
#pragma unroll
                        for (int e = 0; e < 8; ++e) r[e] = mine[e] * tb[e] + sg * oth[e] * tb[8 + e];
                        f[kt * 2] = pack8(r);
                    }
                }
                asm volatile("s_waitcnt vmcnt(0)" ::: "memory");
#pragma unroll
                for (int kt = 0; kt < 4; ++kt) { float a0[8], a1[8]; unpack8(f[kt * 2], a0); unpack8(f[kt * 2 + 1], a1); const u32x2 lo = pk8_fp8(a0), hi = pk8_fp8(a1);
                    u32x4 o; o.x = lo.x; o.y = lo.y; o.z = hi.x; o.w = hi.y; *(u32x4*)((char*)tp + (kt * 64 + lane) * 16) = o; }
            } else {
#pragma unroll
                for (int i = 0; i < 8; ++i) { const int idx = i * 64 + lane, r = idx >> 3, ch = idx & 7; *(LAS u32x4*)(tl + r * 72 + ch * 8) = *(const u32x4*)(tp + r * 64 + ch * 8); }
                asm volatile("s_waitcnt vmcnt(0) lgkmcnt(0)" ::: "memory");
#pragma unroll
                for (int hf = 0; hf < 2; ++hf)
#pragma unroll
                    for (int dp = 0; dp < 2; ++dp) {
                        u32x2 h2[2];
#pragma unroll
                        for (int d2 = 0; d2 < 2; ++d2) { const int dt = dp * 2 + d2; float fv[8];
#pragma unroll
                            for (int j = 0; j < 4; ++j) { fv[j] = bflo((unsigned)tl[(hf * 32 + fq * 4 + j) * 72 + dt * 16 + fr]); fv[4 + j] = bflo((unsigned)tl[(hf * 32 + 16 + fq * 4 + j) * 72 + dt * 16 + fr]); }
                            h2[d2] = pk8_fp8(fv); }
                        u32x4 o; o.x = h2[0].x; o.y = h2[0].y; o.z = h2[1].x; o.w = h2[1].y;
                        *(u32x4*)((char*)tp + ((hf * 2 + dp) * 64 + lane) * 16) = o;
                    }
                asm volatile("s_waitcnt lgkmcnt(0)" ::: "memory");
            }
        }
    }
}

__device__ __forceinline__ void phaseC2(const Prm& p, LAS unsigned char* L, int G) {
    const int tid = threadIdx.x, lane = tid & 63, wave = tid >> 6, fr = lane & 15, fq = lane >> 4;
    unsigned char* ws = p.ws;
    LAS bf16_t* Qs = (LAS bf16_t*)L;
    LAS bf16_t* Ks = (LAS bf16_t*)(L + 33792);
    LAS bf16_t* Ss = (LAS bf16_t*)(L + 67584);
    LAS float* sc = (LAS float*)(L + 76800);
    const bf16_t* MQr = (const bf16_t*)(ws + WS_MQ); const bf16_t* MKr = (const bf16_t*)(ws + WS_MK);
    bf16_t* Qt = (bf16_t*)p.out; bf16_t* KT = Qt + (size_t)M * 1024; bf16_t* SP = (bf16_t*)(ws + WS_SP);
    for (int u = blockIdx.x; u < 1024; u += G) {
        const int bh = u >> 7, c = u & 127, b = bh >> 2, h = bh & 3; const size_t row0 = (size_t)b * T + c * 64; const int s0i = bh * T + c * 64;
        const float* lcf = (const float*)(ws + OFF_LCF); const float* mtv = (const float*)(ws + OFF_MT); const float* liv = (const float*)(ws + OFF_LI);
#pragma unroll
        for (int which = 0; which < 2; ++which) {
            const bf16_t* src = (which ? MKr : MQr) + h * 256 + (tid & 31) * 8; const float* cw = (which ? p.ckw : p.cqw) + h * 256 + (tid & 31) * 8; const float* cb = (which ? p.ckb : p.cqb) + h * 256 + (tid & 31) * 8;
            const float osc = which ? 0.0625f : 1.0f; LAS bf16_t* dstl = which ? Ks : Qs;
            float w0[8], w1[8], w2[8], w3[8], bs[8];
#pragma unroll
            for (int e = 0; e < 8; ++e) { w0[e] = cw[e]; w1[e] = cw[1024 + e]; w2[e] = cw[2048 + e]; w3[e] = cw[3072 + e]; bs[e] = cb[e]; }
#pragma unroll
            for (int i = 0; i < 4; ++i) { const int r = (tid + i * 512) >> 5; const int tt = c * 64 + r;
                u32x4 x0 = {0u, 0u, 0u, 0u}, x1 = x0, x2 = x0; const bf16_t* rp = src + (row0 + r) * 1024;
                if (tt >= 3) x0 = *(const u32x4*)(rp - 3 * 1024);
                if (tt >= 2) x1 = *(const u32x4*)(rp - 2 * 1024);
                if (tt >= 1) x2 = *(const u32x4*)(rp - 1 * 1024);
                const u32x4 x3 = *(const u32x4*)rp;
                float a0[8], a1[8], a2[8], a3[8], o[8]; unpack8(x0, a0); unpack8(x1, a1); unpack8(x2, a2); unpack8(x3, a3);
#pragma unroll
                for (int e = 0; e < 8; ++e) { const float v = bs[e] + w0[e] * a0[e] + w1[e] * a1[e] + w2[e] * a2[e] + w3[e] * a3[e]; o[e] = siluf_(v) * osc; }
                *(LAS u32x4*)(dstl + r * 264 + (tid & 31) * 8) = pack8(o); }
        }
        if (tid < 64) { const float lc = lcf[s0i + tid], mt_ = mtv[s0i + tid], li_ = liv[s0i + tid]; const float lce = lcf[s0i + 63], mte = mtv[s0i + 63];
            sc[tid] = lc; sc[64 + tid] = mt_; sc[128 + tid] = li_; sc[192 + tid] = 0.f; sc[256 + tid] = __expf(lce - lc + li_ - mte);
            if (tid == 0) { const float pF = c ? lcf[s0i - 1] : 0.f, pM = c ? mtv[s0i - 1] : 0.f; sc[320] = pM - pF; sc[321] = mte - lce; } }
        __syncthreads();
        const float Rprev = sc[320];
        {
            const int lt = wave >> 1, st0 = (wave & 1) * 2;
            f32x4 acc[2] = {{0.f, 0.f, 0.f, 0.f}, {0.f, 0.f, 0.f, 0.f}};
#pragma unroll
            for (int ks = 0; ks < 8; ++ks) {
                const bf16x8 a = *(const LAS bf16x8*)(Qs + (lt * 16 + fr) * 264 + ks * 32 + fq * 8);
                const bf16x8 b0 = *(const LAS bf16x8*)(Ks + (st0 * 16 + fr) * 264 + ks * 32 + fq * 8);
                const bf16x8 b1 = *(const LAS bf16x8*)(Ks + ((st0 + 1) * 16 + fr) * 264 + ks * 32 + fq * 8);
                acc[0] = mfma16(a, b0, acc[0]); acc[1] = mfma16(a, b1, acc[1]);
            }
            float rp[4] = {0.f, 0.f, 0.f, 0.f};
#pragma unroll
            for (int i = 0; i < 2; ++i) { const int s = (st0 + i) * 16 + fr; const float cs = sc[128 + s] - sc[s];
#pragma unroll
                for (int j = 0; j < 4; ++j) { const int l = lt * 16 + fq * 4 + j;
                    const float v = (s <= l) ? acc[i][j] * __expf(sc[l] + cs - sc[64 + l]) : 0.f;
                    const unsigned bfv = f2bf(v); Ss[l * 72 + s] = (bf16_t)bfv; rp[j] += bflo(bfv); } }
#pragma unroll
            for (int j = 0; j < 4; ++j) { float v = rp[j]; v += __shfl_xor(v, 1); v += __shfl_xor(v, 2); v += __shfl_xor(v, 4); v += __shfl_xor(v, 8);
                if (fr == 0) atomicAdd((float*)(sc + 192 + lt * 16 + fq * 4 + j), v); }
        }
        __syncthreads();
        {
            { const int r = tid >> 3, ch = tid & 7; *(u32x4*)(SP + (size_t)u * 4096 + r * 64 + ch * 8) = *(const LAS u32x4*)(Ss + r * 72 + ch * 8); }
            if (tid < 64) ((float*)(ws + OFF_RS))[s0i + tid] = sc[192 + tid];
            if (tid == 0) ((float*)(ws + OFF_DEC))[u] = __expf(Rprev - sc[321]);
#pragma unroll
            for (int i = 0; i < 4; ++i) { const int idx = tid + i * 512, r = idx >> 5, ch = idx & 31;
                const float w = __expf(Rprev - (sc[64 + r] - sc[r]));
                float q[8]; unpack8(*(const LAS u32x4*)(Qs + r * 264 + ch * 8), q);
#pragma unroll
                for (int e = 0; e < 8; ++e) q[e] *= w;
                *(u32x4*)(Qt + (row0 + r) * 1024 + h * 256 + ch * 8) = pack8(q); }
            float* kn = (float*)(ws + WS_KN) + (size_t)u * 256;
#pragma unroll
            for (int i = 0; i < 4; ++i) { const int idx = tid + i * 512, d = idx >> 3, scn = idx & 7, s0 = scn * 8;
                float kv[8]; float sum = 0.f; unsigned hb[8];
#pragma unroll
                for (int j = 0; j < 8; ++j) { const float v = bflo((unsigned)Ks[(s0 + j) * 264 + d]) * sc[256 + s0 + j]; hb[j] = f2bf(v); kv[j] = bflo(hb[j]); sum += kv[j]; }
                u32x4 o; o.x = hb[0] | (hb[1] << 16); o.y = hb[2] | (hb[3] << 16); o.z = hb[4] | (hb[5] << 16); o.w = hb[6] | (hb[7] << 16);
                *(u32x4*)(KT + (size_t)u * 16384 + d * 64 + s0) = o;
                sum += __shfl_xor(sum, 1); sum += __shfl_xor(sum, 2); sum += __shfl_xor(sum, 4);
                if (scn == 0) kn[d] = sum; }
        }
        __syncthreads();
    }
}

__device__ __forceinline__ void mlstm_scan(const Prm& p, LAS unsigned char* L) {
    const int tid = threadIdx.x, lane = tid & 63, wave = tid >> 6, fr = lane & 15, fq = lane >> 4;
    unsigned char* ws = p.ws;
    const int mb = blockIdx.x >> 2, bh = mb >> 3, es = mb & 7, b = bh >> 2, h = bh & 3;
    LAS bf16_t* Qs = (LAS bf16_t*)L;
    LAS bf16_t* Ss = (LAS bf16_t*)(L + 33792);
    LAS bf16_t* VTs = (LAS bf16_t*)(L + 43008);
    LAS bf16_t* CTs = (LAS bf16_t*)(L + 47616);
    LAS float* dcs = (LAS float*)(L + 64512);
    const bf16_t* Qt = (const bf16_t*)p.out; const bf16_t* KT = Qt + (size_t)M * 1024; const bf16_t* SP = (const bf16_t*)(ws + WS_SP);
    const bf16_t* MV = (const bf16_t*)(ws + WS_MV); bf16_t* NUM = (bf16_t*)(ws + WS_NUM); const float* dec = (const float*)(ws + OFF_DEC);
    for (int i = tid; i < 32 * 264 / 2; i += NTHR) ((LAS unsigned*)CTs)[i] = 0u;
    if (tid < 128) dcs[tid] = dec[bh * 128 + tid];
    f32x4 acc[2][2];
#pragma unroll
    for (int i = 0; i < 2; ++i)
#pragma unroll
        for (int e = 0; e < 2; ++e) acc[i][e] = (f32x4){0.f, 0.f, 0.f, 0.f};
    u32x4 rqA[4], rsA, rvA, rqB[4], rsB, rvB; bf16x8 kA[4], kB[4], kc[4];
    const int qr[4] = {tid >> 5, (tid + 512) >> 5, (tid + 1024) >> 5, (tid + 1536) >> 5}; const int qch = tid & 31;
    const int sr = tid >> 3, sch = tid & 7;
    const int vr = tid & 63, vch = (tid >> 6) & 3;
#define MS_LOAD(c, X) do { const size_t row0 = (size_t)b * T + (size_t)(c) * 64; const size_t u = (size_t)bh * 128 + (c); \
        _Pragma("unroll") for (int i = 0; i < 4; ++i) rq##X[i] = *(const u32x4*)(Qt + (row0 + qr[i]) * 1024 + h * 256 + qch * 8); \
        _Pragma("unroll") for (int i = 0; i < 2; ++i) _Pragma("unroll") for (int ks = 0; ks < 2; ++ks) k##X[i * 2 + ks] = *(const bf16x8*)(KT + u * 16384 + (size_t)((2 * wave + i) * 16 + fr) * 64 + ks * 32 + fq * 8); \
        rs##X = *(const u32x4*)(SP + u * 4096 + tid * 8); if (tid < 256) rv##X = *(const u32x4*)(MV + (row0 + vr) * 1024 + h * 256 + es * 32 + vch * 8); } while (0)
#define MS_STORE(X) do { \
        _Pragma("unroll") for (int i = 0; i < 4; ++i) { *(LAS u32x4*)(Qs + qr[i] * 264 + qch * 8) = rq##X[i]; kc[i] = k##X[i]; } \
        *(LAS u32x4*)(Ss + sr * 72 + sch * 8) = rs##X; \
        if (tid < 256) { \
        VTs[(vch * 8 + 0) * 72 + vr] = (bf16_t)(rv##X.x & 0xffffu); VTs[(vch * 8 + 1) * 72 + vr] = (bf16_t)(rv##X.x >> 16); VTs[(vch * 8 + 2) * 72 + vr] = (bf16_t)(rv##X.y & 0xffffu); VTs[(vch * 8 + 3) * 72 + vr] = (bf16_t)(rv##X.y >> 16); \
        VTs[(vch * 8 + 4) * 72 + vr] = (bf16_t)(rv##X.z & 0xffffu); VTs[(vch * 8 + 5) * 72 + vr] = (bf16_t)(rv##X.z >> 16); VTs[(vch * 8 + 6) * 72 + vr] = (bf16_t)(rv##X.w & 0xffffu); VTs[(vch * 8 + 7) * 72 + vr] = (bf16_t)(rv##X.w >> 16); } } while (0)
    const int lt = wave >> 1, et = wave & 1;
#define MS_BODY(c, LDSET, STSET) do { \
        const float dc = dcs[(c)]; \
        if ((c) + 2 < 128) MS_LOAD((c) + 2, LDSET); \
        f32x4 na = {0.f, 0.f, 0.f, 0.f}; \
        _Pragma("unroll") for (int ks = 0; ks < 8; ++ks) na = mfma16(*(const LAS bf16x8*)(Qs + (lt * 16 + fr) * 264 + ks * 32 + fq * 8), *(const LAS bf16x8*)(CTs + (et * 16 + fr) * 264 + ks * 32 + fq * 8), na); \
        _Pragma("unroll") for (int ks = 0; ks < 2; ++ks) na = mfma16(*(const LAS bf16x8*)(Ss + (lt * 16 + fr) * 72 + ks * 32 + fq * 8), *(const LAS bf16x8*)(VTs + (et * 16 + fr) * 72 + ks * 32 + fq * 8), na); \
        {   const size_t row0 = (size_t)b * T + (size_t)(c) * 64; \
            _Pragma("unroll") for (int j = 0; j < 4; ++j) NUM[(row0 + lt * 16 + fq * 4 + j) * 1024 + h * 256 + es * 32 + et * 16 + fr] = (bf16_t)f2bf(na[j]); } \
        _Pragma("unroll") for (int i = 0; i < 2; ++i) _Pragma("unroll") for (int e = 0; e < 2; ++e) acc[i][e] *= dc; \
        _Pragma("unroll") for (int ks = 0; ks < 2; ++ks) _Pragma("unroll") for (int e = 0; e < 2; ++e) { const bf16x8 bv = *(const LAS bf16x8*)(VTs + (e * 16 + fr) * 72 + ks * 32 + fq * 8); \
                acc[0][e] = mfma16(kc[ks], bv, acc[0][e]); acc[1][e] = mfma16(kc[2 + ks], bv, acc[1][e]); } \
        __syncthreads(); \
        _Pragma("unroll") for (int i = 0; i < 2; ++i) _Pragma("unroll") for (int e = 0; e < 2; ++e) { u32x2 o; o.x = pk2(acc[i][e][0], acc[i][e][1]); o.y = pk2(acc[i][e][2], acc[i][e][3]); \
                *(LAS u32x2*)(CTs + (e * 16 + fr) * 264 + (2 * wave + i) * 16 + fq * 4) = o; } \
        if ((c) + 1 < 128) MS_STORE(STSET); \
        __syncthreads(); } while (0)
    MS_LOAD(0, A); MS_STORE(A);
    MS_LOAD(1, B);
    __syncthreads();
    for (int c = 0; c < 128; c += 2) {
        MS_BODY(c, A, B);
        MS_BODY(c + 1, B, A);
    }
#undef MS_BODY
#undef MS_LOAD
#undef MS_STORE
}

__device__ __forceinline__ void st_tile(const bf16_t* Kp, const bf16x8 (&qf)[2], int fr, int fq, f32x4 (&st)[4]) {
#pragma unroll
    for (int kt = 0; kt < 4; ++kt) {
        f32x4 a = {0.f, 0.f, 0.f, 0.f};
#pragma unroll
        for (int ks = 0; ks < 2; ++ks) a = mfma16(*(const bf16x8*)(Kp + (size_t)(kt * 16 + fr) * 64 + ks * 32 + fq * 8), qf[ks], a);
        st[kt] = a;
    }
}
__device__ __forceinline__ void pv_tile(const bf16_t* VTp, int vp, const f32x4 (&pr)[4], int fr, int fq, f32x4 (&o)[4]) {
#pragma unroll
    for (int i = 0; i < 2; ++i) {
        u32x4 pw; pw.x = pk2(pr[2 * i][0], pr[2 * i][1]); pw.y = pk2(pr[2 * i][2], pr[2 * i][3]); pw.z = pk2(pr[2 * i + 1][0], pr[2 * i + 1][1]); pw.w = pk2(pr[2 * i + 1][2], pr[2 * i + 1][3]);
        const bf16x8 pb = __builtin_bit_cast(bf16x8, pw);
#pragma unroll
        for (int dt = 0; dt < 4; ++dt) {
            const bf16_t* r = VTp + (size_t)(dt * 16 + fr) * vp + i * 32 + fq * 4;
            const u32x2 lo = *(const u32x2*)r, hi = *(const u32x2*)(r + 16);
            u32x4 vw; vw.x = lo.x; vw.y = lo.y; vw.z = hi.x; vw.w = hi.y;
            o[dt] = mfma16(__builtin_bit_cast(bf16x8, vw), pb, o[dt]);
        }
    }
}
__device__ __forceinline__ void st_tile_frag(const bf16_t* Kt, const bf16x8 (&qf)[2], int lane, f32x4 (&st)[4]) {
#pragma unroll
    for (int kt = 0; kt < 4; ++kt) { f32x4 a = {0.f, 0.f, 0.f, 0.f};
        a = mfma16(*(const bf16x8*)(Kt + ((kt * 2) * 64 + lane) * 8), qf[0], a); a = mfma16(*(const bf16x8*)(Kt + ((kt * 2 + 1) * 64 + lane) * 8), qf[1], a); st[kt] = a; }
}
__device__ __forceinline__ void pv_tile_frag(const bf16_t* Vt, const f32x4 (&pr)[4], int lane, f32x4 (&o)[4]) {
#pragma unroll
    for (int i = 0; i < 2; ++i) {
        u32x4 pw; pw.x = pk2(pr[2 * i][0], pr[2 * i][1]); pw.y = pk2(pr[2 * i][2], pr[2 * i][3]); pw.z = pk2(pr[2 * i + 1][0], pr[2 * i + 1][1]); pw.w = pk2(pr[2 * i + 1][2], pr[2 * i + 1][3]);
        const bf16x8 pb = __builtin_bit_cast(bf16x8, pw);
#pragma unroll
        for (int dt = 0; dt < 4; ++dt) o[dt] = mfma16(*(const bf16x8*)(Vt + ((i * 4 + dt) * 64 + lane) * 8), pb, o[dt]);
    }
}
template <bool FULL>
__device__ __forceinline__ void cmp_p1_tile(f32x4 (&st)[4], int tile, int fq, int nc_col, float& m2, float& l) {
    constexpr float C = 0.125f * 1.4426950408889634f;
    float mx = -1e30f;
#pragma unroll
    for (int kt = 0; kt < 4; ++kt)
#pragma unroll
        for (int j = 0; j < 4; ++j) if (FULL || (tile * 64 + kt * 16 + fq * 4 + j < nc_col)) mx = fmaxf(mx, st[kt][j]);
    mx = fmaxf(mx, __shfl_xor(mx, 16)); mx = fmaxf(mx, __shfl_xor(mx, 32));
    const float mn2 = fmaxf(m2, mx * C); float ps = 0.f;
#pragma unroll
    for (int kt = 0; kt < 4; ++kt)
#pragma unroll
        for (int j = 0; j < 4; ++j) if (FULL || (tile * 64 + kt * 16 + fq * 4 + j < nc_col)) ps += __builtin_amdgcn_exp2f(__builtin_fmaf(st[kt][j], C, -mn2));
    l = l * __builtin_amdgcn_exp2f(m2 - mn2) + ps; m2 = mn2;
}
template <bool FULL>
__device__ __forceinline__ void cmp_p2_tile(f32x4 (&st)[4], int tile, int fq, int nc_col, float off2) {
    constexpr float C = 0.125f * 1.4426950408889634f;
#pragma unroll
    for (int kt = 0; kt < 4; ++kt)
#pragma unroll
        for (int j = 0; j < 4; ++j) st[kt][j] = (FULL || (tile * 64 + kt * 16 + fq * 4 + j < nc_col)) ? __builtin_amdgcn_exp2f(__builtin_fmaf(st[kt][j], C, off2)) : 0.f;
}
__device__ __forceinline__ void online_step(f32x4 (&st)[4], unsigned vmask, float& m, float& l, f32x4 (&o)[4]) {
    float mx = -1e30f;
#pragma unroll
    for (int kt = 0; kt < 4; ++kt)
#pragma unroll
        for (int j = 0; j < 4; ++j) if ((vmask >> (kt * 4 + j)) & 1u) mx = fmaxf(mx, st[kt][j]);
    mx = fmaxf(mx, __shfl_xor(mx, 16)); mx = fmaxf(mx, __shfl_xor(mx, 32));
    const float mn = fmaxf(m, mx); const float alpha = __expf(m - mn);
    float ps = 0.f;
#pragma unroll
    for (int kt = 0; kt < 4; ++kt)
#pragma unroll
        for (int j = 0; j < 4; ++j) { const float pv = ((vmask >> (kt * 4 + j)) & 1u) ? __expf(st[kt][j] - mn) : 0.f; st[kt][j] = pv; ps += pv; }
    ps += __shfl_xor(ps, 16); ps += __shfl_xor(ps, 32);
    l = l * alpha + ps; m = mn;
#pragma unroll
    for (int dt = 0; dt < 4; ++dt) o[dt] *= alpha;
}
__device__ __forceinline__ void load_tile8(const bf16_t* Kt, const bf16_t* Vt, int lane, u32x4 (&k)[4], u32x4 (&v)[4]) {
#pragma unroll
    for (int i = 0; i < 4; ++i) { k[i] = *(const u32x4*)((const char*)Kt + (i * 64 + lane) * 16);
                                  v[i] = *(const u32x4*)((const char*)Vt + (i * 64 + lane) * 16); }
}
template <bool FULL>
__device__ __forceinline__ void tile_step8(const u32x4 (&k)[4], const u32x4 (&v)[4], const u32x2 (&qf)[2], unsigned vm, float& m2, float& l, f32x4 (&o)[4]) {
    constexpr float C = 0.125f * 1.4426950408889634f;
    f32x4 st[4];
#pragma unroll
    for (int kt = 0; kt < 4; ++kt) { f32x4 a = {0.f, 0.f, 0.f, 0.f}; a = mfma8(k[kt].x, k[kt].y, qf[0], a); a = mfma8(k[kt].z, k[kt].w, qf[1], a); st[kt] = a; }
    float mx = -1e30f;
#pragma unroll
    for (int kt = 0; kt < 4; ++kt)
#pragma unroll
        for (int j = 0; j < 4; ++j) if (FULL || ((vm >> (kt * 4 + j)) & 1u)) mx = fmaxf(mx, st[kt][j]);
    mx = fmaxf(mx, __shfl_xor(mx, 16)); mx = fmaxf(mx, __shfl_xor(mx, 32));
    const float mn2 = fmaxf(m2, mx * C); const float alpha = __builtin_amdgcn_exp2f(m2 - mn2); const float off = 8.f - mn2;
    float ps = 0.f;
#pragma unroll
    for (int kt = 0; kt < 4; ++kt)
#pragma unroll
        for (int j = 0; j < 4; ++j) { const float pv = (FULL || ((vm >> (kt * 4 + j)) & 1u)) ? __builtin_amdgcn_exp2f(__builtin_fmaf(st[kt][j], C, off)) : 0.f; st[kt][j] = pv; ps += pv; }
    l = l * alpha + ps; m2 = mn2;
#pragma unroll
    for (int dt = 0; dt < 4; ++dt) o[dt] *= alpha;
#pragma unroll
    for (int hf = 0; hf < 2; ++hf) {
        u32x2 pb; pb.x = pk4_fp8(st[2 * hf][0], st[2 * hf][1], st[2 * hf][2], st[2 * hf][3]); pb.y = pk4_fp8(st[2 * hf + 1][0], st[2 * hf + 1][1], st[2 * hf + 1][2], st[2 * hf + 1][3]);
#pragma unroll
        for (int dp = 0; dp < 2; ++dp) { o[2 * dp] = mfma8(v[hf * 2 + dp].x, v[hf * 2 + dp].y, pb, o[2 * dp]); o[2 * dp + 1] = mfma8(v[hf * 2 + dp].z, v[hf * 2 + dp].w, pb, o[2 * dp + 1]); }
    }
}
__device__ __forceinline__ void tile_step8_dup(const u32x4 (&k)[4], const u32x4 (&v)[4], const u32x2 (&qf)[2], int g, float& m2, float& l, f32x4 (&o)[4]) {
    constexpr float C = 0.125f * 1.4426950408889634f;
    f32x4 st[4];
#pragma unroll
    for (int kt = 0; kt < 4; ++kt) { f32x4 a = {0.f, 0.f, 0.f, 0.f}; a = mfma8(k[kt].x, k[kt].y, qf[0], a); a = mfma8(k[kt].z, k[kt].w, qf[1], a); st[kt] = a; }
    const bool g1 = (g & 1) != 0, g2 = (g & 2) != 0;
    float my[4];
#pragma unroll
    for (int j = 0; j < 4; ++j) { const float lo = g1 ? st[1][j] : st[0][j], hi = g1 ? st[3][j] : st[2][j]; my[j] = g2 ? hi : lo; }
    float mx = fmaxf(fmaxf(my[0], my[1]), fmaxf(my[2], my[3]));
    mx = fmaxf(mx, dpp_f(mx, 2)); mx = fmaxf(mx, dpp_f(mx, 3));
    mx = fmaxf(mx, __shfl_xor(mx, 16)); mx = fmaxf(mx, __shfl_xor(mx, 32));
    const float mn2 = fmaxf(m2, mx * C); const float alpha = __builtin_amdgcn_exp2f(m2 - mn2); const float off = 8.f - mn2;
    float ps = 0.f;
#pragma unroll
    for (int j = 0; j < 4; ++j) { my[j] = __builtin_amdgcn_exp2f(__builtin_fmaf(my[j], C, off)); ps += my[j]; }
    l = l * alpha + ps; m2 = mn2;
#pragma unroll
    for (int dt = 0; dt < 4; ++dt) o[dt] *= alpha;
    const unsigned pk = pk4_fp8(my[0], my[1], my[2], my[3]);
#pragma unroll
    for (int hf = 0; hf < 2; ++hf) {
        u32x2 pb; pb.x = (g == 2 * hf) ? pk : 0u; pb.y = (g == 2 * hf + 1) ? pk : 0u;
#pragma unroll
        for (int dp = 0; dp < 2; ++dp) { o[2 * dp] = mfma8(v[hf * 2 + dp].x, v[hf * 2 + dp].y, pb, o[2 * dp]); o[2 * dp + 1] = mfma8(v[hf * 2 + dp].z, v[hf * 2 + dp].w, pb, o[2 * dp + 1]); }
    }
}
template <class Stream>
__device__ __forceinline__ void attend_stream_dup(int ntiles, const Stream& S, const u32x2 (&qf)[2], int lane, float& m, float& l, f32x4 (&o)[4]) {
    const int g = (lane & 15) >> 2;
    u32x4 k0[4], k1[4], v0[4], v1[4];
    const bf16_t* Kp; const bf16_t* Vp;
    S.addr(0, Kp, Vp); load_tile8(Kp, Vp, lane, k0, v0);
    for (int n = 0; n < ntiles; n += 2) {
        if (n + 1 < ntiles) { S.addr(n + 1, Kp, Vp); load_tile8(Kp, Vp, lane, k1, v1); }
        tile_step8_dup(k0, v0, qf, g, m, l, o);
        if (n + 1 < ntiles) {
            if (n + 2 < ntiles) { S.addr(n + 2, Kp, Vp); load_tile8(Kp, Vp, lane, k0, v0); }
            tile_step8_dup(k1, v1, qf, g, m, l, o);
        }
    }
    l += dpp_f(l, 2); l += dpp_f(l, 3);
#pragma unroll
    for (int dt = 0; dt < 4; ++dt)
#pragma unroll
        for (int j = 0; j < 4; ++j) { float x = o[dt][j]; x += dpp_f(x, 2); x += dpp_f(x, 3); o[dt][j] = x; }
}
struct WinStream {
    const bf16_t* Kb; const bf16_t* Vb; int k00, tcol, t0;
    __device__ __forceinline__ bool full(int n) const { const int k0 = k00 + 64 * n; return (k0 + 63 <= t0) && (t0 + 3 - k0 < 512); }
    __device__ __forceinline__ void addr(int n, const bf16_t*& Kp, const bf16_t*& Vp) const { const size_t o = (size_t)((k00 >> 6) + n) * 4096; Kp = Kb + o; Vp = Vb + o; }
    __device__ __forceinline__ unsigned mask(int n, int fq) const { unsigned vm = 0u; const int k0 = k00 + 64 * n + fq * 4;
#pragma unroll
        for (int kt = 0; kt < 4; ++kt)
#pragma unroll
            for (int j = 0; j < 4; ++j) { const int df = tcol - (k0 + kt * 16 + j); if (df >= 0 && df < 512) vm |= 1u << (kt * 4 + j); }
        return vm; }
};
struct ForcedStream {
    const bf16_t* Kb; const bf16_t* Vb; int nf, cur, tcol;
    __device__ __forceinline__ int blk(int i) const { return i == 0 ? 0 : (i == nf - 1 ? cur : cur - 1); }
    __device__ __forceinline__ bool full(int n) const { return blk(n) < cur; }
    __device__ __forceinline__ void addr(int n, const bf16_t*& Kp, const bf16_t*& Vp) const { const size_t o = (size_t)blk(n) * 4096; Kp = Kb + o; Vp = Vb + o; }
    __device__ __forceinline__ unsigned mask(int n, int fq) const { unsigned vm = 0u; const int k0 = blk(n) * 64 + fq * 4;
#pragma unroll
        for (int kt = 0; kt < 4; ++kt)
#pragma unroll
            for (int j = 0; j < 4; ++j) if (k0 + kt * 16 + j <= tcol) vm |= 1u << (kt * 4 + j);
        return vm; }
};
struct SelStream {
    const bf16_t* Kb; const bf16_t* Vb; int sel, lb, t;
    __device__ __forceinline__ bool full(int) const { return true; }
    __device__ __forceinline__ void addr(int n, const bf16_t*& Kp, const bf16_t*& Vp) const { const size_t o = (size_t)__shfl(sel, lb + n) * 4096; Kp = Kb + o; Vp = Vb + o; }
    __device__ __forceinline__ unsigned mask(int n, int fq) const { unsigned vm = 0u; const int k0 = __shfl(sel, lb + n) * 64 + fq * 4;
#pragma unroll
        for (int kt = 0; kt < 4; ++kt)
#pragma unroll
            for (int j = 0; j < 4; ++j) if (k0 + kt * 16 + j <= t) vm |= 1u << (kt * 4 + j);
        return vm; }
};
template <class Stream>
__device__ __forceinline__ void attend_stream(int ntiles, const Stream& S, const u32x2 (&qf)[2], int lane, float& m, float& l, f32x4 (&o)[4]) {
    const int fq = lane >> 4;
    u32x4 k0[4], k1[4], v0[4], v1[4];
    const bf16_t* Kp; const bf16_t* Vp;
    S.addr(0, Kp, Vp); load_tile8(Kp, Vp, lane, k0, v0);
    for (int n = 0; n < ntiles; n += 2) {
        if (n + 1 < ntiles) { S.addr(n + 1, Kp, Vp); load_tile8(Kp, Vp, lane, k1, v1); }
        if (S.full(n)) tile_step8<true>(k0, v0, qf, 0u, m, l, o); else tile_step8<false>(k0, v0, qf, S.mask(n, fq), m, l, o);
        if (n + 1 < ntiles) {
            if (n + 2 < ntiles) { S.addr(n + 2, Kp, Vp); load_tile8(Kp, Vp, lane, k0, v0); }
            if (S.full(n + 1)) tile_step8<true>(k1, v1, qf, 0u, m, l, o); else tile_step8<false>(k1, v1, qf, S.mask(n + 1, fq), m, l, o);
        }
    }
}
__device__ __forceinline__ void load_q8(const bf16_t* nq, const float* rope, int bt, int head, int fq, u32x2 (&qf)[2]) {
    const bf16_t* qp = nq + (size_t)bt * 512 + head * 64 + fq * 8;
    const u32x4 q0 = *(const u32x4*)qp; const u32x4 q1 = *(const u32x4*)(qp + 32);
    u32x4 ot; ot.x = __shfl_xor(q0.x, 16); ot.y = __shfl_xor(q0.y, 16); ot.z = __shfl_xor(q0.z, 16); ot.w = __shfl_xor(q0.w, 16);
    float a[8], b[8]; unpack8(q0, a); unpack8(q1, b);
    if (fq < 2) {
        const float* tb = rope + (size_t)bt * 16; float oth[8]; unpack8(ot, oth);
        const float sg = fq == 0 ? -1.f : 1.f;
#pragma unroll
        for (int e = 0; e < 8; ++e) a[e] = a[e] * tb[e] + sg * oth[e] * tb[8 + e];
    }
    qf[0] = pk8_fp8(a); qf[1] = pk8_fp8(b);
}
template <bool ROPE>
__device__ __forceinline__ void load_q(const bf16_t* nq, const float* rope, int bt, int head, int fq, bf16x8 (&qf)[2]) {
    const bf16_t* qp = nq + (size_t)bt * 512 + head * 64 + fq * 8;
    u32x4 q0 = *(const u32x4*)qp; const u32x4 q1 = *(const u32x4*)(qp + 32);
    if (ROPE) {
        u32x4 ot; ot.x = __shfl_xor(q0.x, 16); ot.y = __shfl_xor(q0.y, 16); ot.z = __shfl_xor(q0.z, 16); ot.w = __shfl_xor(q0.w, 16);
        if (fq < 2) {
            const float* tb = rope + (size_t)bt * 16; float mine[8], oth[8], r[8]; unpack8(q0, mine); unpack8(ot, oth);
            const float sg = fq == 0 ? -1.f : 1.f;
#pragma unroll
            for (int e = 0; e < 8; ++e) r[e] = mine[e] * tb[e] + sg * oth[e] * tb[8 + e];
            q0 = pack8(r);
        }
    }
    qf[0] = __builtin_bit_cast(bf16x8, q0); qf[1] = __builtin_bit_cast(bf16x8, q1);
}
__device__ __forceinline__ void nsa_unit(const Prm& p, int unit, LAS float* impL, int lane) {
    const int fr = lane & 15, fq = lane >> 4;
    unsigned char* ws = p.ws;
    const int bg = unit >> 11, t0 = (unit & 2047) * 4, b = bg >> 1, g = bg & 1;
    const int qi = fr >> 2, hh = fr & 3, head = g * 4 + hh, tcol = t0 + qi, btcol = b * T + tcol;
    const bf16_t* nq = (const bf16_t*)(ws + WS_NQ); const float* rope = (const float*)(ws + OFF_ROPE);
    const bf16_t* kvrm = (const bf16_t*)(ws + WS_KVRM);
    float g0, g1, g2;
    { const float* gp = (const float*)(ws + WS_GATES) + (size_t)btcol * 32 + 8 + head * 3; const float* bn = p.bng + head * 3;
      g0 = sigmoidf_(gp[0] + bn[0]); g1 = sigmoidf_(gp[1] + bn[1]); g2 = sigmoidf_(gp[2] + bn[2]); }
    f32x4 tot[4];
    {
        bf16x8 qf[2]; load_q<false>(nq, rope, btcol, head, fq, qf);
        const int nc_col = tcol >= 31 ? ((tcol - 31) >> 4) + 1 : 0;
        const int nc_max = (t0 + 3) >= 31 ? ((t0 + 3 - 31) >> 4) + 1 : 0;
        const int ntl = (nc_max + 63) >> 6;
        const bf16_t* Kb = (const bf16_t*)(ws + WS_KC) + (size_t)bg * 512 * 64; const bf16_t* Vb = (const bf16_t*)(ws + WS_VCT) + (size_t)bg * 512 * 64;
        const int nc_t0 = t0 >= 31 ? ((t0 - 31) >> 4) + 1 : 0;
        float m = -1e30f, l = 0.f;
        for (int tile = 0; tile < ntl; ++tile) {
            f32x4 st[4]; st_tile_frag(Kb + (size_t)tile * 4096, qf, lane, st);
            if (tile * 64 + 63 < nc_t0) cmp_p1_tile<true>(st, tile, fq, nc_col, m, l); else cmp_p1_tile<false>(st, tile, fq, nc_col, m, l);
        }
        l += __shfl_xor(l, 16); l += __shfl_xor(l, 32);
        const float off2 = l > 0.f ? -m - __builtin_amdgcn_logf(l) : -1e30f;
        for (int j = lane; j < 1024; j += 64) impL[j] = 0.f;
        LDS_WAIT();
        f32x4 oc[4];
#pragma unroll
        for (int dt = 0; dt < 4; ++dt) oc[dt] = (f32x4){0.f, 0.f, 0.f, 0.f};
        for (int tile = 0; tile < ntl; ++tile) {
            f32x4 st[4]; st_tile_frag(Kb + (size_t)tile * 4096, qf, lane, st);
            if (tile * 64 + 63 < nc_t0) cmp_p2_tile<true>(st, tile, fq, nc_col, off2); else cmp_p2_tile<false>(st, tile, fq, nc_col, off2);
#pragma unroll
            for (int kt = 0; kt < 4; ++kt) {
                float s4 = (st[kt][0] + st[kt][1]) + (st[kt][2] + st[kt][3]); float p3 = st[kt][3];
                s4 += dpp_f(s4, 0); s4 += dpp_f(s4, 1); p3 += dpp_f(p3, 0); p3 += dpp_f(p3, 1);
                if (hh == 0) { impL[qi * 128 + tile * 16 + kt * 4 + fq] = s4; impL[512 + qi * 128 + tile * 16 + kt * 4 + fq] = p3; }
            }
            pv_tile_frag(Vb + (size_t)tile * 4096, st, lane, oc);
        }
#pragma unroll
        for (int dt = 0; dt < 4; ++dt) tot[dt] = oc[dt] * g0;
    }
    LDS_WAIT();
    int selall = 0;
    {
        const int rq = lane >> 4, c = lane & 15, tq = t0 + rq, curq = tq >> 6;
        unsigned key[8];
#pragma unroll
        for (int e = 0; e < 8; ++e) { const int j = e * 16 + c;
            const float iv = impL[rq * 128 + j] + (j > 0 ? impL[512 + rq * 128 + j - 1] : 0.f);
            const bool forced = (j == 0) || (j == curq) || (j == curq - 1), valid = j * 64 <= tq;
            const unsigned rank = forced ? 0x1FFFFFFu : (valid ? ((__builtin_bit_cast(unsigned, fmaxf(iv, 0.f)) >> 7) + 1u) : 0u);
            key[e] = (rank << 7) | (unsigned)(127 - j); }
        for (int n = 0; n < 16; ++n) {
            unsigned lm = key[0];
#pragma unroll
            for (int e = 1; e < 8; ++e) lm = lm > key[e] ? lm : key[e];
            const unsigned rm = row16_max_u32(lm);
            if (c == n) selall = 127 - (int)(rm & 127u);
#pragma unroll
            for (int e = 0; e < 8; ++e) if (key[e] == rm) key[e] = 0u;
        }
    }
    const int nf = (t0 >> 6) == 0 ? 1 : ((t0 >> 6) == 1 ? 2 : 3);
    float ms = -1e30f, ls = 0.f; f32x4 osh[4];
#pragma unroll
    for (int dt = 0; dt < 4; ++dt) osh[dt] = (f32x4){0.f, 0.f, 0.f, 0.f};
    {
        u32x2 qf[2]; load_q8(nq, rope, btcol, head, fq, qf);
        f32x4 ow[4];
#pragma unroll
        for (int dt = 0; dt < 4; ++dt) ow[dt] = (f32x4){0.f, 0.f, 0.f, 0.f};
        float m = -1e30f, l = 0.f;
        const int klo = t0 - 511 > 0 ? t0 - 511 : 0; const int tlo = klo >> 6, thi = (t0 + 3) >> 6;
        WinStream W; W.Kb = kvrm + (size_t)3 * (4 * T * 64) + (size_t)bg * T * 64; W.Vb = kvrm + (size_t)5 * (4 * T * 64) + (size_t)bg * T * 64; W.k00 = tlo * 64; W.tcol = tcol; W.t0 = t0;
        attend_stream(thi - tlo + 1, W, qf, lane, m, l, ow);
        l += __shfl_xor(l, 16); l += __shfl_xor(l, 32);
        const float sc_ = g2 / l;
#pragma unroll
        for (int dt = 0; dt < 4; ++dt) tot[dt] += ow[dt] * sc_;
        ForcedStream F_; F_.Kb = kvrm + (size_t)2 * (4 * T * 64) + (size_t)bg * T * 64; F_.Vb = kvrm + (size_t)4 * (4 * T * 64) + (size_t)bg * T * 64; F_.nf = nf; F_.cur = t0 >> 6; F_.tcol = tcol;
        attend_stream(nf, F_, qf, lane, ms, ls, osh);
    }
    {
#pragma unroll 1
        for (int r = 0; r < 4; ++r) {
            const int t = t0 + r;
            u32x2 qf[2]; load_q8(nq, rope, b * T + t, head, fq, qf);
            f32x4 os[4];
#pragma unroll
            for (int dt = 0; dt < 4; ++dt) os[dt] = (f32x4){0.f, 0.f, 0.f, 0.f};
            float m = -1e30f, l = 0.f;
            SelStream S_; S_.Kb = kvrm + (size_t)2 * (4 * T * 64) + (size_t)bg * T * 64; S_.Vb = kvrm + (size_t)4 * (4 * T * 64) + (size_t)bg * T * 64; S_.sel = selall; S_.lb = r * 16 + nf; S_.t = t;
            const int nv = (t >> 6) + 1 < 16 ? (t >> 6) + 1 : 16;
            if (nv > nf) {
                attend_stream_dup(nv - nf, S_, qf, lane, m, l, os);
                if (qi == r) {
                    const float mn = fmaxf(ms, m), a1 = __builtin_amdgcn_exp2f(ms - mn), a2 = __builtin_amdgcn_exp2f(m - mn);
                    ls = ls * a1 + l * a2; ms = mn;
#pragma unroll
                    for (int dt = 0; dt < 4; ++dt) osh[dt] = osh[dt] * a1 + os[dt] * a2;
                }
            }
        }
        ls += __shfl_xor(ls, 16); ls += __shfl_xor(ls, 32);
        const float scs = g1 / ls;
#pragma unroll
        for (int dt = 0; dt < 4; ++dt) tot[dt] += osh[dt] * scs;
    }
    bf16_t* yn = (bf16_t*)(ws + WS_YN) + (size_t)btcol * 512 + head * 64 + fq * 4;
#pragma unroll
    for (int dt = 0; dt < 4; ++dt) { u32x2 o; o.x = pk2(tot[dt][0], tot[dt][1]); o.y = pk2(tot[dt][2], tot[dt][3]); *(u32x2*)(yn + dt * 16) = o; }
}
__device__ __forceinline__ void phaseC3(const Prm& p, LAS unsigned char* L, int G) {
    const int tid = threadIdx.x, lane = tid & 63, wave = tid >> 6;
    unsigned char* ws = p.ws;
    if (((int)blockIdx.x & 3) == 0 && ((int)blockIdx.x >> 2) < NBM) mlstm_scan(p, L);
    if ((int)blockIdx.x == 1) {
        const int bh = wave; const float* kn = (const float*)(ws + WS_KN); float* np = (float*)(ws + WS_NPREV); const float* dec = (const float*)(ws + OFF_DEC);
        f32x4 n = {0.f, 0.f, 0.f, 0.f};
        for (int c = 0; c < 128; ++c) { const size_t u = (size_t)bh * 128 + c;
            *(f32x4*)(np + u * 256 + lane * 4) = n; const f32x4 k = *(const f32x4*)(kn + u * 256 + lane * 4); n = n * dec[u] + k; }
    }
    LAS float* impL = (LAS float*)(L + wave * 4096);
    unsigned* ctr = (unsigned*)(ws + OFF_CTR);
    const int x0 = (int)blockIdx.x & 7;
    for (int dx = 0; dx < 8; ++dx) {
        const int x = (x0 + dx) & 7;
        for (;;) {
            unsigned u = 0u; if (lane == 0) u = atomicAdd(ctr + x * 8, 1u);
            u = (unsigned)__shfl((int)u, 0);
            if (u >= 1024u) break;
            nsa_unit(p, (x >> 1) * 2048 + 2 * (1023 - (int)u) + (x & 1), impL, lane);
        }
    }
}

__device__ __forceinline__ void phaseC4(const Prm& p, int G) {
    const int tid = threadIdx.x, lane = tid & 63, wave = tid >> 6;
    unsigned char* ws = p.ws;
    const bf16_t* Qt = (const bf16_t*)p.out; bf16_t* NUM = (bf16_t*)(ws + WS_NUM);
    const float* np = (const float*)(ws + WS_NPREV); const float* rs = (const float*)(ws + OFF_RS); const float* mtv = (const float*)(ws + OFF_MT);
    for (int u = blockIdx.x; u < 1024; u += G) {
        const int bh = u >> 7, c = u & 127, b = bh >> 2, h = bh & 3;
        const f32x4 n4 = *(const f32x4*)(np + (size_t)u * 256 + lane * 4); const f32x4 g4 = *(const f32x4*)(p.mhg + h * 256 + lane * 4);
#pragma unroll
        for (int rr = 0; rr < 8; ++rr) {
            const int l = wave * 8 + rr; const size_t row = (size_t)b * T + c * 64 + l; const int si = bh * T + c * 64 + l;
            const u32x2 qw = *(const u32x2*)(Qt + row * 1024 + h * 256 + lane * 4);
            const float dot = wave_sum((bflo(qw.x) * n4[0] + bfhi(qw.x) * n4[1]) + (bflo(qw.y) * n4[2] + bfhi(qw.y) * n4[3]));
            const float den = dot + rs[si]; const float dd = fmaxf(fabsf(den), __expf(-mtv[si])); const float idd = 1.f / dd;
            bf16_t* npnt = NUM + row * 1024 + h * 256 + lane * 4; const u32x2 nw = *(const u32x2*)npnt;
            const float h0 = bflo(nw.x) * idd, h1 = bfhi(nw.x) * idd, h2 = bflo(nw.y) * idd, h3 = bfhi(nw.y) * idd;
            const float mu = wave_sum((h0 + h1) + (h2 + h3)) * (1.f / 256.f);
            const float d0 = h0 - mu, d1 = h1 - mu, d2 = h2 - mu, d3 = h3 - mu;
            const float var = wave_sum((d0 * d0 + d1 * d1) + (d2 * d2 + d3 * d3)) * (1.f / 256.f);
            const float rsd = 1.f / sqrtf(var + EPS);
            u32x2 o; o.x = pk2(d0 * rsd * g4[0], d1 * rsd * g4[1]); o.y = pk2(d2 * rsd * g4[2], d3 * rsd * g4[3]);
            *(u32x2*)npnt = o;
        }
    }
}
__device__ __forceinline__ void phaseG(const Prm& p, int G) {
    const int tid = threadIdx.x, lane = tid & 63, wave = tid >> 6; const int gw = blockIdx.x * NWAVES + wave, NGW = G * NWAVES;
    const float* rowss = (const float*)(p.ws + OFF_RSS16);
#pragma unroll 4
    for (int m = gw; m < M; m += NGW) {
        float ssum = 0.f;
#pragma unroll
        for (int k = 0; k < 16; ++k) ssum += rowss[(size_t)m * 16 + k];
        const float r = 1.f / sqrtf(ssum * (1.f / D) + EPS);
        f32x4* o = (f32x4*)(p.out + (size_t)m * D) + lane; const f32x4* gr = (const f32x4*)p.fng + lane;
#pragma unroll
        for (int j = 0; j < 4; ++j) { const f32x4 v = o[64 * j], g = gr[64 * j]; o[64 * j] = (f32x4){v[0] * r * g[0], v[1] * r * g[1], v[2] * r * g[2], v[3] * r * g[3]}; }
    }
}

#define XB_TMO      128
#define XB_XCNT(j)  (256  + 64 * (j))
#define XB_XSUB(j)  (1280 + 64 * (j))
#define XB_XGEN(j)  (2304 + 64 * (j))
#define XB_TOP      3328
#define XB_TOPGEN   3392
#define XCD_BAR_WORDS 3456
#define XB_SPIN_CAP (1u << 18)

__device__ __forceinline__ unsigned xb_ld(unsigned* p)              { return __hip_atomic_load(p, __ATOMIC_RELAXED, __HIP_MEMORY_SCOPE_AGENT); }
__device__ __forceinline__ unsigned xb_add(unsigned* p, unsigned v) { return __hip_atomic_fetch_add(p, v, __ATOMIC_RELAXED, __HIP_MEMORY_SCOPE_AGENT); }
__device__ __forceinline__ unsigned xb_xcc_id() { return (unsigned)__builtin_amdgcn_s_getreg((3 << 11) | 20) & 0xFu; }
#define XB_SPIN(cond, bar) do { unsigned _sp = 0; while (cond) { __builtin_amdgcn_s_sleep(1); \
    if ((++_sp & 255u) == 0u) { if (xb_ld(&(bar)[XB_TMO])) break; if (_sp > XB_SPIN_CAP) { atomicAdd(&(bar)[XB_TMO], 1u); break; } } } } while (0)

struct XcdBarrier {
    unsigned* bar; unsigned x;
    volatile LAS unsigned* st;
};

__device__ __forceinline__ XcdBarrier xcd_barrier_post(unsigned* bar, volatile LAS unsigned* st) {
    XcdBarrier b; b.bar = bar; b.x = xb_xcc_id(); b.st = st;
    if (threadIdx.x == 0) (void)xb_add(&bar[XB_XCNT(b.x)], 1u);
    return b;
}
__device__ __forceinline__ void xcd_barrier_complete(unsigned* bar, unsigned x, unsigned& nloc, unsigned& nx) {
    const unsigned G = gridDim.x * gridDim.y * gridDim.z;
    unsigned sum, cnt, mine, sp = 0u;
    for (;;) {
        sum = 0u; cnt = 0u; mine = 0u;
#pragma unroll
        for (unsigned j = 0; j < 16; ++j) { const unsigned c = xb_ld(&bar[XB_XCNT(j)]); sum += c; cnt += (c > 0u) ? 1u : 0u; mine = (j == x) ? c : mine; }
        if (sum == G) break;
        __builtin_amdgcn_s_sleep(1);
        if ((++sp & 255u) == 0u) { if (xb_ld(&bar[XB_TMO])) break; if (sp > XB_SPIN_CAP) { atomicAdd(&bar[XB_TMO], 1u); break; } }
    }
    nloc = mine > 0u ? mine : 1u; nx = cnt > 0u ? cnt : 1u;
}

__device__ __forceinline__ void xcd_barrier(const XcdBarrier& b) {
    asm volatile("s_waitcnt vmcnt(0)" ::: "memory");
    __syncthreads();
    if (threadIdx.x == 0) {
        unsigned* bar = b.bar;
        __builtin_amdgcn_s_waitcnt(0);
        unsigned nloc = b.st[0], nx = b.st[1];
        if (nloc == 0u) { xcd_barrier_complete(bar, b.x, nloc, nx); b.st[0] = nloc; b.st[1] = nx; }
        const unsigned old = xb_add(&bar[XB_XSUB(b.x)], 1u);
        const unsigned gen = old / nloc;
        if (old + 1u == (gen + 1u) * nloc) {
            __builtin_amdgcn_fence(__ATOMIC_RELEASE, "agent");
            asm volatile("s_waitcnt vmcnt(0)" ::: "memory");
            const unsigned og = xb_add(&bar[XB_TOP], 1u);
            const unsigned tg = og / nx;
            if (og + 1u == (tg + 1u) * nx) xb_add(&bar[XB_TOPGEN], 1u);
            else XB_SPIN(xb_ld(&bar[XB_TOPGEN]) == tg, bar);
            __builtin_amdgcn_fence(__ATOMIC_ACQUIRE, "agent");
            xb_add(&bar[XB_XGEN(b.x)], 1u);
            asm volatile("s_waitcnt vmcnt(0)" ::: "memory");
        } else {
            XB_SPIN(xb_ld(&bar[XB_XGEN(b.x)]) == gen, bar);
            __builtin_amdgcn_fence(__ATOMIC_ACQUIRE, "agent");
            asm volatile("s_waitcnt vmcnt(0)" ::: "memory");
        }
    }
    __syncthreads();
}

constexpr int N_PHASES = 11;
__global__ void __launch_bounds__(NTHR, 2) fwd_kernel(Prm p) {
    extern __shared__ __attribute__((aligned(16))) unsigned char lds[];
    LAS unsigned char* L = (LAS unsigned char*)lds;
    const int G = gridDim.x;
    unsigned char* ws = p.ws;
    const int lo = p.ph_lo, hi = p.ph_hi;
    volatile LAS unsigned* bst = (volatile LAS unsigned*)(L + 135168);
    if (threadIdx.x < 2) bst[threadIdx.x] = 0u;
    __syncthreads();
    XcdBarrier bar; bar.bar = (unsigned*)(ws + OFF_BAR); bar.x = 0; bar.st = nullptr;
    if (p.coop) bar = xcd_barrier_post((unsigned*)(ws + OFF_BAR), bst);
#define IN(k) (lo <= (k) && (k) < hi)
#define SEAM(k) do { if (p.coop && IN((k) + 1)) { xcd_barrier(bar); } } while (0)
    if (IN(0)) { phaseA(p, L, G); SEAM(0); }
    if (IN(1)) {
        pg8::Gemm g{(const bf16_t*)(ws + WS_XN), (const bf16_t*)(ws + WS_WIN), M, N1, D}; pg8::StaticOrder S; S.init(M, N1, G, (int)blockIdx.x);
        EpiP1 E{(bf16_t*)(ws + WS_MQ), (bf16_t*)(ws + WS_NQ), (bf16_t*)(ws + WS_KVRM), (bf16_t*)(ws + WS_VT), (float*)(ws + WS_GATES)};
        pg8::gemm_phase<EpiP1, pg8::StaticOrder, true, true>(L, g, S, E);
        deferred_weights(p, L, G);
        SEAM(1);
    }
    if (IN(2)) { phaseC1(p, L, G); SEAM(2); }
    if (IN(3)) { phaseC2(p, L, G); SEAM(3); }
    if (IN(4)) { phaseC3(p, L, G); SEAM(4); }
    if (IN(5)) { phaseC4(p, G); SEAM(5); }
    if (IN(6)) {
        pg8::Gemm g{(const bf16_t*)(ws + WS_XN), (const bf16_t*)(ws + WS_WIN) + (size_t)N1 * D, M, N2, D}; pg8::StaticOrder S; S.init(M, N2, G, (int)blockIdx.x);
        EpiP2 E{(bf16_t*)(ws + WS_NUM), (bf16_t*)(ws + WS_YN), (bf16_t*)(ws + WS_MQ), (bf16_t*)(ws + WS_MK)};
        pg8::gemm_phase<EpiP2, pg8::StaticOrder, true, true>(L, g, S, E);
        SEAM(6);
    }
    if (IN(7)) {
        pg8::Gemm g{(const bf16_t*)(ws + WS_NUM), (const bf16_t*)(ws + WS_WA), M, D, D}; pg8::StaticOrder S; S.init(M, D, G, (int)blockIdx.x);
        EpiE1 E{(const bf16_t*)(ws + WS_MQ), (bf16_t*)p.out};
        pg8::gemm_phase<EpiE1, pg8::StaticOrder, true, true>(L, g, S, E);
    }
    if (IN(8)) {
        pg8::Gemm g{(const bf16_t*)(ws + WS_YN), (const bf16_t*)(ws + WS_WB), M, D, 512}; pg8::StaticOrder S; S.init(M, D, G, (int)blockIdx.x);
        EpiE2 E{(const bf16_t*)(ws + WS_MK), (const bf16_t*)p.out, (bf16_t*)(ws + WS_XN)};
        pg8::gemm_phase<EpiE2, pg8::StaticOrder, true, true>(L, g, S, E);
        SEAM(8);
    }
    if (IN(9)) {
        pg8::Gemm g{(const bf16_t*)(ws + WS_XN), (const bf16_t*)(ws + WS_WO), M, D, D}; pg8::StaticOrder S; S.init(M, D, G, (int)blockIdx.x);
        EpiFN E{p.x, p.out, p.fng, (float*)(ws + OFF_RSS16), (unsigned*)(ws + OFF_BAR + 14 * KiB)};
        pg8::gemm_phase<EpiFN, pg8::StaticOrder, false, true>(L, g, S, E);
    }
#undef IN
#undef SEAM
}

#ifndef MK_COOP
#define MK_COOP 1
#endif
extern "C" void kernel_launch(void* const* d_in, const int* in_sizes, int n_in, void* d_out, int out_size, void* d_ws, size_t ws_size, hipStream_t stream) {
    static int grid = 0;
    if (grid == 0) {
        int dev = 0, cus = 0, per_cu = 0;
        if (n_in != 22 || ws_size < WS_END) { fprintf(stderr, "kernel_launch: unexpected n_in %d / ws %zu\n", n_in, ws_size); grid = -1; return; }
        (void)hipGetDevice(&dev); (void)hipDeviceGetAttribute(&cus, hipDeviceAttributeMultiprocessorCount, dev);
        if (hipFuncSetAttribute((const void*)fwd_kernel, hipFuncAttributeMaxDynamicSharedMemorySize, LDS_BYTES) != hipSuccess) { fprintf(stderr, "kernel_launch: hipFuncSetAttribute failed\n"); grid = -1; return; }
        if (hipOccupancyMaxActiveBlocksPerMultiprocessor(&per_cu, (const void*)fwd_kernel, NTHR, LDS_BYTES) != hipSuccess || per_cu < 1) { fprintf(stderr, "kernel_launch: occupancy query gave %d\n", per_cu); per_cu = 1; }
        (void)hipGetLastError();
        grid = cus * (per_cu > 1 ? 1 : per_cu);
        if (grid < NBM * 4) { fprintf(stderr, "kernel_launch: grid %d too small\n", grid); grid = -1; return; }
    }
    if (grid < 0) return;
    Prm p{};
    p.x = (const float*)d_in[0]; p.pos = (const int*)d_in[1]; p.norm_g = (const float*)d_in[2]; p.w_in = (const float*)d_in[3];
    p.cqw = (const float*)d_in[4]; p.cqb = (const float*)d_in[5]; p.ckw = (const float*)d_in[6]; p.ckb = (const float*)d_in[7];
    p.big = (const float*)d_in[8]; p.bfg = (const float*)d_in[9]; p.mhg = (const float*)d_in[10];
    p.cpk = (const float*)d_in[11]; p.cw1k = (const float*)d_in[12]; p.cw2k = (const float*)d_in[13];
    p.cpv = (const float*)d_in[14]; p.cw1v = (const float*)d_in[15]; p.cw2v = (const float*)d_in[16];
    p.bng = (const float*)d_in[17]; p.wa = (const float*)d_in[18]; p.wb = (const float*)d_in[19]; p.wo = (const float*)d_in[20]; p.fng = (const float*)d_in[21];
    p.out = (float*)d_out; p.ws = (unsigned char*)d_ws;
#if MK_COOP
    (void)hipMemsetAsync((char*)d_ws + OFF_BAR, 0, 16 * KiB, stream);
    p.ph_lo = 0; p.ph_hi = N_PHASES; p.coop = 1; p.pad = 0;
    void* args[] = {&p};
    hipError_t e = hipLaunchCooperativeKernel((const void*)fwd_kernel, dim3(grid), dim3(NTHR), args, LDS_BYTES, stream);
    if (e != hipSuccess) fprintf(stderr, "kernel_launch: cooperative launch failed: %s (grid %d)\n", hipGetErrorString(e), grid);
#else
    for (int ph = 0; ph < N_PHASES; ++ph) {
        p.ph_lo = ph; p.ph_hi = ph + 1; p.coop = 0; p.pad = 0;
        hipLaunchKernelGGL(fwd_kernel, dim3(grid), dim3(NTHR), LDS_BYTES, stream, p);
    }
#endif
}
```

```cpp
#include <hip/hip_runtime.h>
#include <hip/hip_cooperative_groups.h>
#include <cstdio>
#include <cstdint>
namespace cg = cooperative_groups;
namespace pg8 {
#define PG8_LAS __attribute__((address_space(3)))
typedef unsigned short bf16_t;
typedef short bf16x8 __attribute__((ext_vector_type(8)));
typedef float f32x4 __attribute__((ext_vector_type(4)));
typedef unsigned u32x4 __attribute__((ext_vector_type(4)));
constexpr int BM = 256, BK = 64, HALF = 128, HTB = HALF * BK * 2  , STAGE_BYTES = 8 * HTB, NXCD = 8, WGM = 8;

__host__ __device__ __forceinline__ int lds_byte(int r, int c) { const int st = (r >> 4) * 2 + (c >> 5), rr = r & 15, cc = c & 31, ob = rr * 64 + cc * 2; return st * 1024 + (ob ^ (((ob >> 9) & 1) << 5)); }
__host__ __device__ __forceinline__ void stage_rc(int b, int& R, int& C) { const int st = b / 1024, sb = b % 1024, swz = sb ^ (((sb >> 9) & 1) << 5); R = (st >> 1) * 16 + swz / 64; C = (st & 1) * 32 + (swz % 64) / 2; }
__host__ __device__ __forceinline__ int perm32(int rho) { const int n = rho >> 4, i = rho & 15; return 8 * (i >> 2) + 4 * n + (i & 3); }

struct Unit { int pm, pn; };
struct Gemm { const bf16_t* A; const bf16_t* Bt; int M, N, K; };

struct StaticOrder {
    int nM, nN, nwg, G, c;
    __host__ __device__ void init(int M, int N, int G_, int c_) { nM = M / BM; nN = N / BM; nwg = nM * nN; G = G_; c = c_; }
    __host__ __device__ bool next(int i, Unit& u) const {
        const long L = (long)i * G + c; if (L >= nwg) return false;
        int wgid = (int)L; { const int q = nwg / NXCD, r = nwg % NXCD, xcd = wgid % NXCD, off = wgid / NXCD; wgid = (xcd < r ? xcd * (q + 1) : r * (q + 1) + (xcd - r) * q) + off; }
        const int nig = WGM * nN, gid = wgid / nig, fm = gid * WGM, gsz = (nM - fm) < WGM ? (nM - fm) : WGM;
        u.pm = fm + ((wgid % nig) % gsz); u.pn = (wgid % nig) / gsz; return true;
    }
    __device__ __forceinline__ void a_ready(const Unit&) const {}
    __device__ __forceinline__ void done(const Unit&) const {}
};

__device__ __forceinline__ unsigned cvt_pk_bf16(float lo, float hi) { unsigned r; asm volatile("v_cvt_pk_bf16_f32 %0, %1, %2" : "=v"(r) : "v"(lo), "v"(hi)); return r; }
template <class Epi, class Sched, bool ALIGN_EPI = false, bool SP2 = false>
__device__ __forceinline__ void gemm_phase(PG8_LAS unsigned char* lds, const Gemm g, const Sched& S, const Epi& E) {
    const int tid = threadIdx.x, wid = __builtin_amdgcn_readfirstlane(tid >> 6), lane = tid & 63, wr = wid >> 2, wc = wid & 3, fr = lane & 15, fq = lane >> 4;
    const int K = g.K, nt = K / BK;
    unsigned voffA[2], voffB[2];
#pragma unroll
    for (int i = 0; i < 2; ++i) { int R, C; stage_rc(tid * 16 + i * 8192, R, C); const int Rb = Epi::PERM ? ((R & ~31) + perm32(R & 31)) : R;
        voffA[i] = (unsigned)(R * K + C) * 2u; voffB[i] = (unsigned)(Rb * K + C) * 2u; }
    const size_t kstep = (size_t)(BK * 2);
    const size_t hstep = (size_t)HALF * K * 2;
    const size_t tstep = 2 * hstep;
    const unsigned ldsw = (unsigned)wid * 1024u;
    const int aoff = lds_byte(wr * 64 + fr, fq * 8), boff = lds_byte(wc * 32 + fr, fq * 8);
#define PG8_SA(b, h) (((b) * 2 + (h)) * HTB)
#define PG8_SB(b, h) ((4 + (b) * 2 + (h)) * HTB)
#define PG8_STAGE(bufoff, gbase, voff) do { _Pragma("unroll") for (int _i = 0; _i < 2; ++_i) \
        __builtin_amdgcn_global_load_lds((const unsigned*)((const char*)(gbase) + (voff)[_i]), (PG8_LAS unsigned*)(lds + (bufoff) + ldsw + _i * 8192), 16, 0, 0); } while (0)
#define PG8_LDA(dst, b, h) do { _Pragma("unroll") for (int m = 0; m < 4; ++m) _Pragma("unroll") for (int k = 0; k < 2; ++k) dst[m][k] = *(const PG8_LAS bf16x8*)(lds + PG8_SA(b, h) + aoff + m * 2048 + k * 1024); } while (0)
#define PG8_LDB(dst, b, h) do { _Pragma("unroll") for (int n = 0; n < 2; ++n) _Pragma("unroll") for (int k = 0; k < 2; ++k) dst[n][k] = *(const PG8_LAS bf16x8*)(lds + PG8_SB(b, h) + boff + n * 2048 + k * 1024); } while (0)
#define PG8_MMA(ai, bj, At, Bt) do { __builtin_amdgcn_s_setprio(1); _Pragma("unroll") for (int m = 0; m < 4; ++m) _Pragma("unroll") for (int n = 0; n < 2; ++n) _Pragma("unroll") for (int k = 0; k < 2; ++k) \
        acc[ai][bj][m][n] = __builtin_amdgcn_mfma_f32_16x16x32_bf16(Bt[n][k], At[m][k], acc[ai][bj][m][n], 0, 0, 0); __builtin_amdgcn_s_setprio(0); } while (0)
#define PG8_WAIT_V(n) asm volatile("s_waitcnt vmcnt(" #n ")" ::: "memory")
#define PG8_WAIT_L(n) asm volatile("s_waitcnt lgkmcnt(" #n ")" ::: "memory")
#define PG8_BAR __builtin_amdgcn_s_barrier()
#define PG8_SCHED __builtin_amdgcn_sched_barrier(0)
    Unit cur, nxt; int ui = 0;
    if (!S.next(0, cur)) return;
    f32x4 acc[2][2][4][2];
#pragma unroll
    for (int a = 0; a < 2; ++a)
#pragma unroll
        for (int b = 0; b < 2; ++b)
#pragma unroll
            for (int m = 0; m < 4; ++m)
#pragma unroll
                for (int n = 0; n < 2; ++n) acc[a][b][m][n] = (f32x4){0.f, 0.f, 0.f, 0.f};
    bf16x8 At[4][2], B0[2][2], B1[2][2];
    const char* cA = (const char*)g.A + (size_t)cur.pm * tstep; const char* cB = (const char*)g.Bt + (size_t)cur.pn * tstep;
    S.a_ready(cur);
    if constexpr (SP2) {
        PG8_STAGE(PG8_SB(0, 0), cB, voffB); PG8_STAGE(PG8_SB(0, 1), cB + hstep, voffB); PG8_STAGE(PG8_SA(0, 0), cA, voffA); PG8_STAGE(PG8_SA(0, 1), cA + hstep, voffA);
        if (wr == 1) PG8_BAR;
        PG8_WAIT_V(2); PG8_BAR;
        PG8_STAGE(PG8_SB(1, 0), cB + kstep, voffB); PG8_STAGE(PG8_SA(1, 0), cA + kstep, voffA); PG8_STAGE(PG8_SB(1, 1), cB + hstep + kstep, voffB);
        PG8_WAIT_V(6); PG8_BAR;
    } else {
        PG8_STAGE(PG8_SB(0, 0), cB, voffB); PG8_STAGE(PG8_SA(0, 0), cA, voffA); PG8_STAGE(PG8_SB(0, 1), cB + hstep, voffB); PG8_STAGE(PG8_SA(0, 1), cA + hstep, voffA);
        if (wr == 1) PG8_BAR;
        PG8_WAIT_V(4); PG8_BAR;
        PG8_STAGE(PG8_SB(1, 0), cB + kstep, voffB); PG8_STAGE(PG8_SA(1, 0), cA + kstep, voffA); PG8_STAGE(PG8_SB(1, 1), cB + hstep + kstep, voffB);
        PG8_WAIT_V(6); PG8_BAR;
    }
    for (;;) {
        const bool has_next = S.next(ui + 1, nxt);
        const char* nA = has_next ? (const char*)g.A + (size_t)nxt.pm * tstep : cA; const char* nB = has_next ? (const char*)g.Bt + (size_t)nxt.pn * tstep : cB;
        for (int t = 0; t < nt; t += 2) {
            const bool last = (t == nt - 2);
            const char* a1 = cA + (size_t)(t + 1) * kstep;
            const char* a2 = last ? nA : cA + (size_t)(t + 2) * kstep; const char* b2 = last ? nB : cB + (size_t)(t + 2) * kstep;
            const char* a3 = a2 + kstep; const char* b3 = b2 + kstep;
            if (last && has_next) S.a_ready(nxt);
            if constexpr (SP2) {
            PG8_LDB(B0, 0, 0); PG8_LDB(B1, 0, 1); PG8_SCHED; PG8_LDA(At, 0, 0); PG8_STAGE(PG8_SA(1, 1), a1 + hstep, voffA);
            PG8_WAIT_V(8); PG8_WAIT_L(0); PG8_BAR; PG8_MMA(0, 0, At, B0); PG8_MMA(0, 1, At, B1); PG8_BAR; PG8_SCHED;
            PG8_LDA(At, 0, 1); PG8_STAGE(PG8_SB(0, 0), b2, voffB); PG8_STAGE(PG8_SB(0, 1), b2 + hstep, voffB); PG8_STAGE(PG8_SA(0, 0), a2, voffA);
            PG8_WAIT_V(8); PG8_WAIT_L(0); PG8_BAR; PG8_MMA(1, 0, At, B0); PG8_MMA(1, 1, At, B1); PG8_BAR; PG8_SCHED;
            PG8_LDB(B0, 1, 0); PG8_LDB(B1, 1, 1); PG8_SCHED; PG8_LDA(At, 1, 0); PG8_STAGE(PG8_SA(0, 1), a2 + hstep, voffA);
            PG8_WAIT_V(8); PG8_WAIT_L(0); PG8_BAR; PG8_MMA(0, 0, At, B0); PG8_MMA(0, 1, At, B1); PG8_BAR; PG8_SCHED;
            PG8_LDA(At, 1, 1); PG8_STAGE(PG8_SB(1, 0), b3, voffB); PG8_STAGE(PG8_SB(1, 1), b3 + hstep, voffB); PG8_STAGE(PG8_SA(1, 0), a3, voffA);
            PG8_WAIT_V(8); PG8_WAIT_L(0); PG8_BAR; PG8_MMA(1, 0, At, B0); PG8_MMA(1, 1, At, B1); PG8_BAR; PG8_SCHED;
            } else {
            PG8_LDB(B0, 0, 0); PG8_SCHED; PG8_LDA(At, 0, 0); PG8_STAGE(PG8_SA(1, 1), a1 + hstep, voffA);
            PG8_WAIT_L(8); PG8_BAR; PG8_WAIT_L(0); PG8_MMA(0, 0, At, B0); PG8_BAR; PG8_SCHED;
            PG8_LDB(B1, 0, 1); PG8_STAGE(PG8_SB(0, 0), b2, voffB);
            PG8_BAR; PG8_WAIT_L(0); PG8_MMA(0, 1, At, B1); PG8_BAR;
            PG8_LDA(At, 0, 1); PG8_STAGE(PG8_SA(0, 0), a2, voffA);
            PG8_BAR; PG8_WAIT_L(0); PG8_MMA(1, 0, At, B0); PG8_BAR; PG8_SCHED;
            PG8_STAGE(PG8_SB(0, 1), b2 + hstep, voffB);
            PG8_WAIT_V(6); PG8_BAR; PG8_MMA(1, 1, At, B1); PG8_BAR;
            PG8_LDB(B0, 1, 0); PG8_SCHED; PG8_LDA(At, 1, 0); PG8_STAGE(PG8_SA(0, 1), a2 + hstep, voffA);
            PG8_WAIT_L(8); PG8_BAR; PG8_WAIT_L(0); PG8_MMA(0, 0, At, B0); PG8_BAR; PG8_SCHED;
            PG8_LDB(B1, 1, 1); PG8_STAGE(PG8_SB(1, 0), b3, voffB);
            PG8_BAR; PG8_WAIT_L(0); PG8_MMA(0, 1, At, B1); PG8_BAR;
            PG8_LDA(At, 1, 1); PG8_STAGE(PG8_SA(1, 0), a3, voffA);
            PG8_BAR; PG8_WAIT_L(0); PG8_MMA(1, 0, At, B0); PG8_BAR; PG8_SCHED;
            PG8_STAGE(PG8_SB(1, 1), b3 + hstep, voffB);
            PG8_WAIT_V(6); PG8_BAR; PG8_MMA(1, 1, At, B1); PG8_BAR;
            }
        }
        if constexpr (ALIGN_EPI) { if (wr == 0) PG8_BAR; }
        if constexpr (!Epi::AFTER_DRAIN) { E(acc, cur, wr, wc, fr, fq); S.done(cur); }
        if (!has_next) break;
#pragma unroll
        for (int a = 0; a < 2; ++a)
#pragma unroll
            for (int b = 0; b < 2; ++b)
#pragma unroll
                for (int m = 0; m < 4; ++m)
#pragma unroll
                    for (int n = 0; n < 2; ++n) acc[a][b][m][n] = (f32x4){0.f, 0.f, 0.f, 0.f};
        cur = nxt; cA = nA; cB = nB; ++ui;
        if constexpr (ALIGN_EPI) { if (wr == 1) PG8_BAR; }
    }
    PG8_WAIT_V(0);
    if constexpr (!ALIGN_EPI) { if (wr == 0) PG8_BAR; }
    PG8_BAR;
    if constexpr (Epi::AFTER_DRAIN) { E.fused(acc, cur, wr, wc, fr, fq, lds, wid, lane); S.done(cur); }
#undef PG8_SA
#undef PG8_SB
#undef PG8_STAGE
#undef PG8_LDA
#undef PG8_LDB
#undef PG8_MMA
#undef PG8_WAIT_V
#undef PG8_WAIT_L
#undef PG8_BAR
#undef PG8_SCHED
}
}

#define LAS __attribute__((address_space(3)))
using pg8::bf16_t; using pg8::bf16x8; using pg8::f32x4; using pg8::u32x4;
typedef short bf16x4 __attribute__((ext_vector_type(4)));
typedef unsigned u32x2 __attribute__((ext_vector_type(2)));
constexpr int BATCH = 2, T = 8192, D = 1024, M = BATCH * T;
constexpr int N1 = 4608, N2 = 4608, INW = 8992;
constexpr float EPS = 1e-6f;
constexpr int NTHR = 512, NWAVES = 8;
constexpr int LDS_BYTES = 147456;
constexpr int MLSTM_E = 32, NBM = 8 * (256 / MLSTM_E);

constexpr size_t MiB = 1u << 20, KiB = 1u << 10;
constexpr size_t OFF_ROWSS = 0, OFF_LCF = 64 * KiB, OFF_MT = 320 * KiB, OFF_LI = 576 * KiB, OFF_RS = 832 * KiB, OFF_DEC = 1088 * KiB, OFF_CTR = 1096 * KiB, OFF_BAR = 1104 * KiB  , OFF_ROPE = 2 * MiB, OFF_RSS16 = 3 * MiB;
constexpr size_t WS_KN = 4 * MiB, WS_NPREV = 5 * MiB, WS_KC = 6 * MiB, WS_VCT = 6 * MiB + 256 * KiB, WS_W1KT = 6 * MiB + 512 * KiB, WS_W1VT = 7 * MiB,
                 WS_W2KT = 7 * MiB + 512 * KiB, WS_W2VT = 7 * MiB + 528 * KiB, WS_GATES = 8 * MiB, WS_WA = 10 * MiB, WS_WO = 12 * MiB, WS_WB = 14 * MiB,
                 WS_WIN = 16 * MiB, WS_SP = 16 * MiB  , WS_XN = 34 * MiB, WS_MQ = 66 * MiB, WS_MK = 98 * MiB, WS_MV = 130 * MiB,
                 WS_NQ = 162 * MiB, WS_KVRM = 178 * MiB, WS_VT = 194 * MiB, WS_NUM = 202 * MiB, WS_YN = 234 * MiB, WS_END = 250 * MiB;

struct Prm {
    const float* x; const int* pos; const float *norm_g, *w_in, *cqw, *cqb, *ckw, *ckb, *big, *bfg, *mhg, *cpk, *cw1k, *cw2k, *cpv, *cw1v, *cw2v, *bng, *wa, *wb, *wo, *fng;
    float* out; unsigned char* ws;
    int ph_lo, ph_hi, coop, pad;
};

__device__ __forceinline__ unsigned f2bf(float f) { unsigned u = __builtin_bit_cast(unsigned, f); return (u + 0x7fffu + ((u >> 16) & 1u)) >> 16; }
__device__ __forceinline__ float bflo(unsigned w) { return __builtin_bit_cast(float, w << 16); }
__device__ __forceinline__ float bfhi(unsigned w) { return __builtin_bit_cast(float, w & 0xffff0000u); }
typedef __bf16 bf16v2_t __attribute__((ext_vector_type(2)));
typedef float f32v2_t __attribute__((ext_vector_type(2)));
__device__ __forceinline__ unsigned pk2(float lo, float hi) { const f32v2_t f = {lo, hi}; const bf16v2_t r = __builtin_convertvector(f, bf16v2_t); return __builtin_bit_cast(unsigned, r); }
__device__ __forceinline__ float sigmoidf_(float v) { return 1.f / (1.f + __expf(-v)); }
__device__ __forceinline__ float siluf_(float v) { return v / (1.f + __expf(-v)); }
#define DPP_I(v, ctrl) __builtin_amdgcn_update_dpp(0, (int)(v), (ctrl), 0xF, 0xF, true)
__device__ __forceinline__ float dpp_f(float v, const int ctrl_sel) {
    const int i = __builtin_bit_cast(int, v);
    const int r = ctrl_sel == 0 ? DPP_I(i, 0xB1) : (ctrl_sel == 1 ? DPP_I(i, 0x4E) : (ctrl_sel == 2 ? DPP_I(i, 0x124) : DPP_I(i, 0x128)));
    return __builtin_bit_cast(float, r);
}
__device__ __forceinline__ float wave_sum(float v) {
    v += dpp_f(v, 0); v += dpp_f(v, 1); v += dpp_f(v, 2); v += dpp_f(v, 3);
    v += __shfl_xor(v, 16); v += __shfl_xor(v, 32);
    return v;
}
__device__ __forceinline__ float wave_max(float v) {
#pragma unroll
    for (int o = 1; o < 64; o <<= 1) v = fmaxf(v, __shfl_xor(v, o));
    return v;
}
#define LDS_WAIT() asm volatile("s_waitcnt lgkmcnt(0)" ::: "memory")
__device__ __forceinline__ f32x4 mfma16(bf16x8 a, bf16x8 b, f32x4 c) { return __builtin_amdgcn_mfma_f32_16x16x32_bf16(a, b, c, 0, 0, 0); }
__device__ __forceinline__ void unpack8(u32x4 w, float (&f)[8]) {
    f[0] = bflo(w.x); f[1] = bfhi(w.x); f[2] = bflo(w.y); f[3] = bfhi(w.y); f[4] = bflo(w.z); f[5] = bfhi(w.z); f[6] = bflo(w.w); f[7] = bfhi(w.w);
}
__device__ __forceinline__ u32x4 pack8(const float (&f)[8]) { u32x4 w; w.x = pk2(f[0], f[1]); w.y = pk2(f[2], f[3]); w.z = pk2(f[4], f[5]); w.w = pk2(f[6], f[7]); return w; }

__device__ __forceinline__ unsigned row16_max_u32(unsigned v) {
    unsigned t;
    t = (unsigned)DPP_I(v, 0xB1); v = v > t ? v : t;
    t = (unsigned)DPP_I(v, 0x4E); v = v > t ? v : t;
    t = (unsigned)DPP_I(v, 0x124); v = v > t ? v : t;
    t = (unsigned)DPP_I(v, 0x128); v = v > t ? v : t;
    return v;
}
typedef unsigned long long u64_t;
__device__ __forceinline__ unsigned pk4_fp8(float a, float b, float c, float d) { int w = __builtin_amdgcn_cvt_pk_fp8_f32(a, b, 0, false); w = __builtin_amdgcn_cvt_pk_fp8_f32(c, d, w, true); return (unsigned)w; }
__device__ __forceinline__ u32x2 pk8_fp8(const float (&f)[8]) { u32x2 r; r.x = pk4_fp8(f[0], f[1], f[2], f[3]); r.y = pk4_fp8(f[4], f[5], f[6], f[7]); return r; }
__device__ __forceinline__ f32x4 mfma8(unsigned alo, unsigned ahi, u32x2 b, f32x4 c) {
    const u32x2 a = {alo, ahi};
    return __builtin_amdgcn_mfma_f32_16x16x32_fp8_fp8(__builtin_bit_cast(long, a), __builtin_bit_cast(long, b), c, 0, 0, 0);
}
struct EpiP1 {
    static constexpr bool PERM = true, AFTER_DRAIN = false;
    bf16_t* mqkv; bf16_t* nq; bf16_t* kvrm; bf16_t* vT; float* gates;
    __device__ __forceinline__ void operator()(const f32x4 (&acc)[2][2][4][2], const pg8::Unit& u, int wr, int wc, int fr, int fq) const {
        const int pn = u.pn; const int row0 = u.pm * 256 + wr * 64 + fr;
#pragma unroll
        for (int ai = 0; ai < 2; ++ai)
#pragma unroll
            for (int m = 0; m < 4; ++m) {
                const int row = row0 + ai * 128 + m * 16; const int b = row >> 13, t = row & (T - 1);
#pragma unroll
                for (int bj = 0; bj < 2; ++bj) {
                    const f32x4 v0 = acc[ai][bj][m][0], v1 = acc[ai][bj][m][1];
                    const int c = pn * 256 + bj * 128 + wc * 32 + 8 * fq;
                    if (pn == 17) {
                        const int cc = c - 4352;
                        if (cc < 32) { float* gp = gates + (size_t)row * 32 + cc; *(f32x4*)gp = v0; *(f32x4*)(gp + 4) = v1; }
                    } else {
                        u32x4 w; w.x = pk2(v0[0], v0[1]); w.y = pk2(v0[2], v0[3]); w.z = pk2(v1[0], v1[1]); w.w = pk2(v1[2], v1[3]);
                        bf16_t* dp;
                        if (pn < 12) { const int arr = pn >> 2; dp = mqkv + (size_t)arr * ((size_t)M * 1024) + (size_t)row * 1024 + (c - arr * 1024); }
                        else if (pn < 14) { dp = nq + (size_t)row * 512 + (c - 3072); }
                        else { const int cc = c - pn * 256; const int seg = cc >> 7, g = (cc >> 6) & 1, d = cc & 63; const int arr = (pn - 14) * 2 + seg;
                               dp = kvrm + (size_t)arr * (4 * T * 64) + (size_t)((b * 2 + g) * T + t) * 64 + d; }
                        *(u32x4*)dp = w;
                    }
                }
            }
    }
};
struct EpiP2 {
    static constexpr bool PERM = true, AFTER_DRAIN = false;
    bf16_t* hn; bf16_t* yn; bf16_t* sga; bf16_t* sgb;
    __device__ __forceinline__ void operator()(const f32x4 (&acc)[2][2][4][2], const pg8::Unit& u, int wr, int wc, int fr, int fq) const {
        const int pn = u.pn; const int row0 = u.pm * 256 + wr * 64 + fr;
#pragma unroll
        for (int ai = 0; ai < 2; ++ai)
#pragma unroll
            for (int m = 0; m < 4; ++m) {
                const int row = row0 + ai * 128 + m * 16;
#pragma unroll
                for (int bj = 0; bj < 2; ++bj) {
                    const f32x4 v0 = acc[ai][bj][m][0], v1 = acc[ai][bj][m][1];
                    const int c = pn * 256 + bj * 128 + wc * 32 + 8 * fq;
                    if (pn < 8) {
                        const int ch = (c >> 3) * 4;
                        bf16_t* hp = hn + (size_t)row * 1024 + ch; const u32x2 hw = *(const u32x2*)hp;
                        const float h0 = bflo(hw.x), h1 = bfhi(hw.x), h2 = bflo(hw.y), h3 = bfhi(hw.y);
                        u32x2 o; o.x = pk2(sigmoidf_(v0[0]) * siluf_(v1[0]) * h0, sigmoidf_(v0[1]) * siluf_(v1[1]) * h1);
                        o.y = pk2(sigmoidf_(v0[2]) * siluf_(v1[2]) * h2, sigmoidf_(v0[3]) * siluf_(v1[3]) * h3);
                        *(u32x2*)hp = o;
                    } else if (pn < 10) {
                        bf16_t* yp = yn + (size_t)row * 512 + (c - 2048); const u32x4 yw = *(const u32x4*)yp; float y[8]; unpack8(yw, y);
                        u32x4 o; o.x = pk2(y[0] * siluf_(v0[0]), y[1] * siluf_(v0[1])); o.y = pk2(y[2] * siluf_(v0[2]), y[3] * siluf_(v0[3]));
                        o.z = pk2(y[4] * siluf_(v1[0]), y[5] * siluf_(v1[1])); o.w = pk2(y[6] * siluf_(v1[2]), y[7] * siluf_(v1[3]));
                        *(u32x4*)yp = o;
                    } else {
                        bf16_t* dp = (pn < 14) ? sga + (size_t)row * 1024 + (c - 2560) : sgb + (size_t)row * 1024 + (c - 3584);
                        u32x4 o; o.x = pk2(sigmoidf_(v0[0]), sigmoidf_(v0[1])); o.y = pk2(sigmoidf_(v0[2]), sigmoidf_(v0[3]));
                        o.z = pk2(sigmoidf_(v1[0]), sigmoidf_(v1[1])); o.w = pk2(sigmoidf_(v1[2]), sigmoidf_(v1[3]));
                        *(u32x4*)dp = o;
                    }
                }
            }
    }
};
struct EpiE1 {
    static constexpr bool PERM = true, AFTER_DRAIN = false;
    const bf16_t* sga; bf16_t* tmp;
    __device__ __forceinline__ void operator()(const f32x4 (&acc)[2][2][4][2], const pg8::Unit& u, int wr, int wc, int fr, int fq) const {
        const int row0 = u.pm * 256 + wr * 64 + fr;
#pragma unroll
        for (int ai = 0; ai < 2; ++ai)
#pragma unroll
            for (int m = 0; m < 4; ++m) {
                const int row = row0 + ai * 128 + m * 16;
#pragma unroll
                for (int bj = 0; bj < 2; ++bj) {
                    const f32x4 v0 = acc[ai][bj][m][0], v1 = acc[ai][bj][m][1];
                    const int c = u.pn * 256 + bj * 128 + wc * 32 + 8 * fq;
                    float s[8]; unpack8(*(const u32x4*)(sga + (size_t)row * 1024 + c), s);
                    u32x4 o; o.x = pk2(v0[0] * s[0], v0[1] * s[1]); o.y = pk2(v0[2] * s[2], v0[3] * s[3]); o.z = pk2(v1[0] * s[4], v1[1] * s[5]); o.w = pk2(v1[2] * s[6], v1[3] * s[7]);
                    *(u32x4*)(tmp + (size_t)row * 1024 + c) = o;
                }
            }
    }
};
struct EpiE2 {
    static constexpr bool PERM = true, AFTER_DRAIN = false;
    const bf16_t* sgb; const bf16_t* tmp; bf16_t* mg;
    __device__ __forceinline__ void operator()(const f32x4 (&acc)[2][2][4][2], const pg8::Unit& u, int wr, int wc, int fr, int fq) const {
        const int row0 = u.pm * 256 + wr * 64 + fr;
#pragma unroll
        for (int ai = 0; ai < 2; ++ai)
#pragma unroll
            for (int m = 0; m < 4; ++m) {
                const int row = row0 + ai * 128 + m * 16;
#pragma unroll
                for (int bj = 0; bj < 2; ++bj) {
                    const f32x4 v0 = acc[ai][bj][m][0], v1 = acc[ai][bj][m][1];
                    const int c = u.pn * 256 + bj * 128 + wc * 32 + 8 * fq;
                    float s[8]; unpack8(*(const u32x4*)(sgb + (size_t)row * 1024 + c), s);
                    float t[8]; unpack8(*(const u32x4*)(tmp + (size_t)row * 1024 + c), t);
                    u32x4 o; o.x = pk2(t[0] + v0[0] * s[0], t[1] + v0[1] * s[1]); o.y = pk2(t[2] + v0[2] * s[2], t[3] + v0[3] * s[3]);
                    o.z = pk2(t[4] + v1[0] * s[4], t[5] + v1[1] * s[5]); o.w = pk2(t[6] + v1[2] * s[6], t[7] + v1[3] * s[7]);
                    *(u32x4*)(mg + (size_t)row * 1024 + c) = o;
                }
            }
    }
};
struct EpiF {
    static constexpr bool PERM = true, AFTER_DRAIN = false;
    const float* x; float* out; float* rowss;
    __device__ __forceinline__ void operator()(const f32x4 (&acc)[2][2][4][2], const pg8::Unit& u, int wr, int wc, int fr, int fq) const {
        const int row0 = u.pm * 256 + wr * 64 + fr;
#pragma unroll
        for (int ai = 0; ai < 2; ++ai)
#pragma unroll
            for (int m = 0; m < 4; ++m) {
                const int row = row0 + ai * 128 + m * 16; float ss = 0.f;
#pragma unroll
                for (int bj = 0; bj < 2; ++bj) {
                    const int c = u.pn * 256 + bj * 128 + wc * 32 + 8 * fq;
                    const float* xp = x + (size_t)row * 1024 + c; float* op = out + (size_t)row * 1024 + c;
                    f32x4 a = *(const f32x4*)xp + acc[ai][bj][m][0], b = *(const f32x4*)(xp + 4) + acc[ai][bj][m][1];
                    *(f32x4*)op = a; *(f32x4*)(op + 4) = b;
                    ss += (a[0] * a[0] + a[1] * a[1]) + (a[2] * a[2] + a[3] * a[3]) + (b[0] * b[0] + b[1] * b[1]) + (b[2] * b[2] + b[3] * b[3]);
                }
                ss += __shfl_xor(ss, 16); ss += __shfl_xor(ss, 32);
                if (fq == 0) rowss[(size_t)row * 16 + u.pn * 4 + wc] = ss;
            }
    }
};

struct EpiFN {
    static constexpr bool PERM = true, AFTER_DRAIN = true;
    const float* x; float* out; const float* fng; float* slots; unsigned* cnt;
    __device__ __forceinline__ void fused(f32x4 (&acc)[2][2][4][2], const pg8::Unit& u, int wr, int wc, int fr, int fq, LAS unsigned char* lds, int wid, int lane) const {
        LAS float* P = (LAS float*)lds;
        LAS float* S = (LAS float*)(lds + 4096);
        const int tid = wid * 64 + lane;
#pragma unroll
        for (int ai = 0; ai < 2; ++ai)
#pragma unroll
            for (int m = 0; m < 4; ++m) {
                const int rl = ai * 128 + wr * 64 + m * 16 + fr; const int row = u.pm * 256 + rl; float ss = 0.f;
#pragma unroll
                for (int bj = 0; bj < 2; ++bj) {
                    const int c = u.pn * 256 + bj * 128 + wc * 32 + 8 * fq; const float* xp = x + (size_t)row * 1024 + c;
                    const f32x4 a = *(const f32x4*)xp + acc[ai][bj][m][0], b = *(const f32x4*)(xp + 4) + acc[ai][bj][m][1];
                    acc[ai][bj][m][0] = a; acc[ai][bj][m][1] = b;
                    ss += (a[0] * a[0] + a[1] * a[1]) + (a[2] * a[2] + a[3] * a[3]) + (b[0] * b[0] + b[1] * b[1]) + (b[2] * b[2] + b[3] * b[3]);
                }
                ss += __shfl_xor(ss, 16); ss += __shfl_xor(ss, 32);
                if (fq == 0) P[rl * 4 + wc] = ss;
            }
        __syncthreads();
        if (tid < 256) { const float t = (P[tid * 4] + P[tid * 4 + 1]) + (P[tid * 4 + 2] + P[tid * 4 + 3]);
            __hip_atomic_store(slots + (size_t)(u.pm * 256 + tid) * 4 + u.pn, t, __ATOMIC_RELAXED, __HIP_MEMORY_SCOPE_AGENT); }
        asm volatile("s_waitcnt vmcnt(0)" ::: "memory");
        __syncthreads();
        if (tid == 0) {
            __hip_atomic_fetch_add(cnt + u.pm, 1u, __ATOMIC_RELEASE, __HIP_MEMORY_SCOPE_AGENT);
            unsigned sp = 0;
            while (__hip_atomic_load(cnt + u.pm, __ATOMIC_ACQUIRE, __HIP_MEMORY_SCOPE_AGENT) < 4u) { __builtin_amdgcn_s_sleep(2); if (++sp > (1u << 22)) break; }
        }
        __syncthreads();
        if (tid < 256) { const float* sl = slots + (size_t)(u.pm * 256 + tid) * 4; float t = 0.f;
#pragma unroll
            for (int k = 0; k < 4; ++k) t += __hip_atomic_load(sl + k, __ATOMIC_RELAXED, __HIP_MEMORY_SCOPE_AGENT);
            S[tid] = 1.f / sqrtf(t * (1.f / 1024.f) + EPS); }
        __syncthreads();
#pragma unroll
        for (int ai = 0; ai < 2; ++ai)
#pragma unroll
            for (int m = 0; m < 4; ++m) {
                const int rl = ai * 128 + wr * 64 + m * 16 + fr; const int row = u.pm * 256 + rl; const float r = S[rl];
#pragma unroll
                for (int bj = 0; bj < 2; ++bj) {
                    const int c = u.pn * 256 + bj * 128 + wc * 32 + 8 * fq; float* op = out + (size_t)row * 1024 + c;
                    const f32x4 g0 = *(const f32x4*)(fng + c), g1 = *(const f32x4*)(fng + c + 4);
                    *(f32x4*)op = acc[ai][bj][m][0] * r * g0; *(f32x4*)(op + 4) = acc[ai][bj][m][1] * r * g1;
                }
            }
    }
};

__device__ __forceinline__ int win_dest(int n) {
    if (n < 3072) return n;
    if (n < 4096) { const int c = n - 3072; return 4608 + 8 * (c >> 2) + (c & 3); }
    if (n < 5120) { const int c = n - 4096; return 4608 + 8 * (c >> 2) + 4 + (c & 3); }
    if (n < 5124) return 4352 + (n - 5120);
    if (n < 5128) return 4356 + (n - 5124);
    if (n < 5640) return 3072 + (n - 5128);
    if (n < 5768) return 3584 + (n - 5640);
    if (n < 5896) return 3712 + (n - 5768);
    if (n < 6024) return 3840 + (n - 5896);
    if (n < 6152) return 4096 + (n - 6024);
    if (n < 6280) return 3968 + (n - 6152);
    if (n < 6408) return 4224 + (n - 6280);
    if (n < 6432) return 4360 + (n - 6408);
    if (n < 6944) return 4608 + 2048 + (n - 6432);
    if (n < 7968) return 4608 + 2560 + (n - 6944);
    return 4608 + 3584 + (n - 7968);
}
template <bool MAP>
__device__ __forceinline__ void transpose_item(const float* W, int K, int N, bf16_t* WT, LAS float* scr, int item, int lane) {
    const int nblk = N / 32, kb = item / nblk, nb = item % nblk, k0 = 64 * kb, n0 = 32 * nb;
#pragma unroll 8
    for (int i = 0; i < 32; ++i) { const int kk = 2 * i + (lane >> 5); scr[kk * 33 + (lane & 31)] = W[(size_t)(k0 + kk) * N + n0 + (lane & 31)]; }
    LDS_WAIT();
    const int c = lane & 7;
#pragma unroll
    for (int j = 0; j < 4; ++j) { const int n = (lane >> 3) + 8 * j; const LAS float* s = scr + (8 * c) * 33 + n;
        u32x4 o; o.x = pk2(s[0 * 33], s[1 * 33]); o.y = pk2(s[2 * 33], s[3 * 33]); o.z = pk2(s[4 * 33], s[5 * 33]); o.w = pk2(s[6 * 33], s[7 * 33]);
        const int row = MAP ? win_dest(n0 + n) : (n0 + n);
        *(u32x4*)(WT + (size_t)row * K + k0 + 8 * c) = o; }
    LDS_WAIT();
}
__device__ __forceinline__ void phaseA(const Prm& p, LAS unsigned char* L, int G) {
    const int tid = threadIdx.x, lane = tid & 63, wave = tid >> 6;
    const int gw = blockIdx.x * NWAVES + wave, NGW = G * NWAVES, gtid = blockIdx.x * NTHR + tid, NT = G * NTHR;
    unsigned char* ws = p.ws;
    LAS float* scr = (LAS float*)(L + wave * 16384);
    constexpr int NB_E = 137, I_WIN = 16 * NB_E, I_W1 = 32 * 4, I_W2 = 2 * 2;
    constexpr int NITEMS = I_WIN + 2 * I_W1 + 2 * I_W2;
    for (int it = gw; it < NITEMS; it += NGW) {
        int r = it;
        if (r < I_WIN) { const int kb = r / NB_E, ib = r % NB_E, nb = ib < 96 ? ib : ib + 64; transpose_item<true>(p.w_in, 1024, INW, (bf16_t*)(ws + WS_WIN), scr, kb * 281 + nb, lane); continue; } r -= I_WIN;
        if (r < I_W1) { transpose_item<false>(p.cw1k, 2048, 128, (bf16_t*)(ws + WS_W1KT), scr, r, lane); continue; } r -= I_W1;
        if (r < I_W1) { transpose_item<false>(p.cw1v, 2048, 128, (bf16_t*)(ws + WS_W1VT), scr, r, lane); continue; } r -= I_W1;
        if (r < I_W2) { transpose_item<false>(p.cw2k, 128, 64, (bf16_t*)(ws + WS_W2KT), scr, r, lane); continue; } r -= I_W2;
        transpose_item<false>(p.cw2v, 128, 64, (bf16_t*)(ws + WS_W2VT), scr, r, lane);
    }
    {
        u32x4* z = (u32x4*)(ws + WS_WIN + (size_t)4384 * 2048);
        for (int i = gtid; i < 224 * 128; i += NT) z[i] = (u32x4){0u, 0u, 0u, 0u};
    }
    bf16_t* XN = (bf16_t*)(ws + WS_XN);
    for (int m0 = gw; m0 < M; m0 += 4 * NGW) {
        f32x4 v[4][4]; float ss[4];
#pragma unroll
        for (int q = 0; q < 4; ++q) { const int m = m0 + q * NGW < M ? m0 + q * NGW : m0; const f32x4* xr = (const f32x4*)(p.x + (size_t)m * D) + lane;
#pragma unroll
            for (int j = 0; j < 4; ++j) v[q][j] = __builtin_nontemporal_load(xr + 64 * j); }
#pragma unroll
        for (int q = 0; q < 4; ++q) { float s_ = 0.f;
#pragma unroll
            for (int j = 0; j < 4; ++j) s_ += (v[q][j][0] * v[q][j][0] + v[q][j][1] * v[q][j][1]) + (v[q][j][2] * v[q][j][2] + v[q][j][3] * v[q][j][3]);
            ss[q] = s_; }
#pragma unroll
        for (int q = 0; q < 4; ++q) ss[q] = wave_sum(ss[q]);
#pragma unroll
        for (int q = 0; q < 4; ++q) { const int m = m0 + q * NGW; if (m < M) {
            const float r = 1.f / sqrtf(ss[q] * (1.f / D) + EPS); const f32x4* gr = (const f32x4*)p.norm_g + lane;
            u32x2* o8 = (u32x2*)(XN + (size_t)m * D) + lane;
#pragma unroll
            for (int j = 0; j < 4; ++j) { const f32x4 g = gr[64 * j]; u32x2 o; o.x = pk2(v[q][j][0] * r * g[0], v[q][j][1] * r * g[1]); o.y = pk2(v[q][j][2] * r * g[2], v[q][j][3] * r * g[3]); o8[64 * j] = o; } } }
    }
    if (blockIdx.x == 0 && tid < 64) ((unsigned*)(ws + OFF_CTR))[tid] = 0u;
    {
        float* tab = (float*)(ws + OFF_ROPE);
        for (int i = gtid; i < M * 8; i += NT) { const int bt = i >> 3, k = i & 7; const float inv = powf(500000.0f, -(float)k * 0.125f);
            const float ang = (float)p.pos[bt] * inv; tab[bt * 16 + k] = cosf(ang); tab[bt * 16 + 8 + k] = sinf(ang); }
    }
}

__device__ __forceinline__ void deferred_weights(const Prm& p, LAS unsigned char* L, int G) {
    const int tid = threadIdx.x, lane = tid & 63, wave = tid >> 6;
    const int half = G / 2; if ((int)blockIdx.x < half) return;
    const int gw = ((int)blockIdx.x - half) * NWAVES + wave, NGW = (G - half) * NWAVES;
    unsigned char* ws = p.ws;
    LAS float* scr = (LAS float*)(L + wave * 16384);
    constexpr int NB_D = 144, I_WIN = 16 * NB_D, I_A = 16 * 32, I_B = 8 * 32, I_O = 16 * 32;
    constexpr int NITEMS = I_WIN + I_A + I_B + I_O;
    for (int it = gw; it < NITEMS; it += NGW) {
        int r = it;
        if (r < I_WIN) { const int kb = r / NB_D, ib = r % NB_D, nb = ib < 64 ? 96 + ib : 201 + (ib - 64); transpose_item<true>(p.w_in, 1024, INW, (bf16_t*)(ws + WS_WIN), scr, kb * 281 + nb, lane); continue; } r -= I_WIN;
        if (r < I_A) { transpose_item<false>(p.wa, 1024, 1024, (bf16_t*)(ws + WS_WA), scr, r, lane); continue; } r -= I_A;
        if (r < I_B) { transpose_item<false>(p.wb, 512, 1024, (bf16_t*)(ws + WS_WB), scr, r, lane); continue; } r -= I_B;
        transpose_item<false>(p.wo, 1024, 1024, (bf16_t*)(ws + WS_WO), scr, r, lane);
    }
}

__device__ __forceinline__ void phaseC1(const Prm& p, LAS unsigned char* L, int G) {
    const int tid = threadIdx.x, lane = tid & 63, wave = tid >> 6, fr = lane & 15, fq = lane >> 4;
    const int gw = blockIdx.x * NWAVES + wave, gtid = blockIdx.x * NTHR + tid, NT = G * NTHR;
    unsigned char* ws = p.ws;
    const float* gates = (const float*)(ws + WS_GATES);
    if (blockIdx.x < 8) {
        const int bh = blockIdx.x, b = bh >> 2, h = bh & 3;
        float* lcf = (float*)(ws + OFF_LCF) + bh * T; float* mtv = (float*)(ws + OFF_MT) + bh * T; float* liv = (float*)(ws + OFF_LI) + bh * T;
        LAS float* red = (LAS float*)L;
        const float bfv = p.bfg[h], biv = p.big[h];
        float cf[16], li[16]; float run = 0.f;
#pragma unroll
        for (int k = 0; k < 16; ++k) { const float* gp = gates + (size_t)(b * T + tid * 16 + k) * 32; const float fp = gp[4 + h] + bfv; li[k] = gp[h] + biv;
            run += fminf(fp, 0.f) - log1pf(expf(-fabsf(fp))); cf[k] = run; }
        float inc = run;
#pragma unroll
        for (int o = 1; o < 64; o <<= 1) { const float v = __shfl_up(inc, o); if (lane >= o) inc += v; }
        if (lane == 63) red[wave] = inc;
        __syncthreads();
        float base = inc - run;
        for (int w = 0; w < wave; ++w) base += red[w];
        float pm[16]; float tm = -INFINITY;
#pragma unroll
        for (int k = 0; k < 16; ++k) { cf[k] += base; tm = fmaxf(tm, li[k] - cf[k]); pm[k] = tm; }
        float incm = tm;
#pragma unroll
        for (int o = 1; o < 64; o <<= 1) { const float v = __shfl_up(incm, o); if (lane >= o) incm = fmaxf(incm, v); }
        if (lane == 63) red[8 + wave] = incm;
        float exm = __shfl_up(incm, 1); if (lane == 0) exm = -INFINITY;
        __syncthreads();
        float R0 = fmaxf(0.f, exm);
        for (int w = 0; w < wave; ++w) R0 = fmaxf(R0, red[8 + w]);
#pragma unroll
        for (int k = 0; k < 16; ++k) { const int t = tid * 16 + k; const float R = fmaxf(R0, pm[k]); lcf[t] = cf[k]; mtv[t] = cf[k] + R; liv[t] = li[k]; }
        __syncthreads();
    }
    {
        LAS bf16_t* H = (LAS bf16_t*)L;
        for (int u = blockIdx.x; u < 256; u += G) {
            const int which = u >> 7, bg = (u >> 5) & 3, it = u & 31;
            const bf16_t* src = (const bf16_t*)(ws + WS_KVRM) + (size_t)which * (4 * T * 64) + (size_t)bg * T * 64;
            const float* pos = which ? p.cpv : p.cpk;
            const bf16_t* w1T = (const bf16_t*)(ws + (which ? WS_W1VT : WS_W1KT)); const bf16_t* w2T = (const bf16_t*)(ws + (which ? WS_W2VT : WS_W2KT));
            const int irow = it * 16 + fr, ic = irow < 511 ? irow : 510;
            const bf16_t* ab = src + (size_t)ic * 1024 + wave * 256; const float* pw = pos + wave * 256; const bf16_t* bb = w1T + (size_t)fr * 2048 + wave * 256;
            f32x4 acc[8];
#pragma unroll
            for (int nt = 0; nt < 8; ++nt) acc[nt] = (f32x4){0.f, 0.f, 0.f, 0.f};
#pragma unroll 2
            for (int ks = 0; ks < 8; ++ks) {
                const int k = ks * 32 + fq * 8;
                float a[8]; unpack8(*(const u32x4*)(ab + k), a);
                const f32x4 p0 = *(const f32x4*)(pw + k), p1 = *(const f32x4*)(pw + k + 4);
                a[0] += p0[0]; a[1] += p0[1]; a[2] += p0[2]; a[3] += p0[3]; a[4] += p1[0]; a[5] += p1[1]; a[6] += p1[2]; a[7] += p1[3];
                const bf16x8 af = __builtin_bit_cast(bf16x8, pack8(a));
#pragma unroll
                for (int nt = 0; nt < 8; ++nt) acc[nt] = mfma16(af, *(const bf16x8*)(bb + (size_t)nt * 16 * 2048 + k), acc[nt]);
            }
            LAS float* Pp = (LAS float*)(L + 8192);
#pragma unroll
            for (int nt = 0; nt < 8; ++nt)
#pragma unroll
                for (int j = 0; j < 4; ++j) Pp[wave * 2048 + (fq * 4 + j) * 128 + nt * 16 + fr] = acc[nt][j];
            __syncthreads();
            {   const int idx = tid * 4; f32x4 sum = *(const LAS f32x4*)(Pp + idx);
#pragma unroll
                for (int w = 1; w < 8; ++w) sum += *(const LAS f32x4*)(Pp + w * 2048 + idx);
                const int i = idx >> 7, n = idx & 127;
#pragma unroll
                for (int j = 0; j < 4; ++j) { const float v = sum[j]; const float gl = 0.5f * v * (1.f + tanhf(0.7978845608028654f * (v + 0.044715f * v * v * v)));
                    H[i * 136 + n + j] = (bf16_t)f2bf(gl); } }
            __syncthreads();
            if (wave < 4) {
                f32x4 a2 = {0.f, 0.f, 0.f, 0.f};
#pragma unroll
                for (int ks = 0; ks < 4; ++ks)
                    a2 = mfma16(*(const LAS bf16x8*)(H + fr * 136 + ks * 32 + fq * 8), *(const bf16x8*)(w2T + (size_t)(wave * 16 + fr) * 128 + ks * 32 + fq * 8), a2);
                const int i0 = it * 16 + fq * 4, d = wave * 16 + fr;
                const int tile = it >> 2, kt = it & 3;
                if (which == 0) { bf16_t* kc = (bf16_t*)(ws + WS_KC) + (size_t)bg * 512 * 64 + tile * 4096;
#pragma unroll
                    for (int j = 0; j < 4; ++j) kc[((kt * 2 + (d >> 5)) * 64 + ((d >> 3) & 3) * 16 + fq * 4 + j) * 8 + (d & 7)] = (i0 + j < 511) ? (bf16_t)f2bf(a2[j]) : (bf16_t)0;
                } else { bf16_t* vc = (bf16_t*)(ws + WS_VCT) + (size_t)bg * 512 * 64 + tile * 4096;
                    u32x2 o; o.x = pk2(a2[0], a2[1]); o.y = pk2(a2[2], (i0 + 3 < 511) ? a2[3] : 0.f);
                    *(u32x2*)(vc + (((kt >> 1) * 4 + wave) * 64 + fq * 16 + fr) * 8 + (kt & 1) * 4) = o; }
            }
            __syncthreads();
        }
    }
    {
        const float* tab = (const float*)(ws + OFF_ROPE);
        LAS bf16_t* tl = (LAS bf16_t*)(L + wave * 16384);
        const int NGW = G * NWAVES;
        for (int item = gw; item < 4 * 4 * 128; item += NGW) {
            const int tile = item & 127, bg = (item >> 7) & 3, arr = 2 + (item >> 9);
            bf16_t* tp = (bf16_t*)(ws + WS_KVRM) + (size_t)arr * (4 * T * 64) + (size_t)(bg * T + tile * 64) * 64;
            if (arr < 4) {
                u32x4 f[8];
#pragma unroll
                for (int kt = 0; kt < 4; ++kt)
#pragma unroll
                    for (int ks = 0; ks < 2; ++ks) f[kt * 2 + ks] = *(const u32x4*)(tp + (kt * 16 + fr) * 64 + ks * 32 + fq * 8);
#pragma unroll
                for (int kt = 0; kt < 4; ++kt) {
                    u32x4 q0 = f[kt * 2];
                    u32x4 ot; ot.x = __shfl_xor(q0.x, 16); ot.y = __shfl_xor(q0.y, 16); ot.z = __shfl_xor(q0.z, 16); ot.w = __shfl_xor(q0.w, 16);
                    if (fq < 2) {
                        const float* tb = tab + (size_t)((bg >> 1) * T + tile * 64 + kt * 16 + fr) * 16; float mine[8], oth[8], r[8]; unpack8(q0, mine); unpack8(ot, oth);
                        const float sg = fq == 0 ? -1.f : 1.f;
#pragma unroll
                        for (int e = 0; e < 8; ++e) r[e] = mine[e] * tb[e] + sg * oth[e] * tb[8 + e];
                        f[kt * 2] = pack8(r);
                    }
                }
                asm volatile("s_waitcnt vmcnt(0)" ::: "memory");
#pragma unroll
                for (int kt = 0; kt < 4; ++kt) { float a0[8], a1[8]; unpack8(f[kt * 2], a0); unpack8(f[kt * 2 + 1], a1); const u32x2 lo = pk8_fp8(a0), hi = pk8_fp8(a1);
                    u32x4 o; o.x = lo.x; o.y = lo.y; o.z = hi.x; o.w = hi.y; *(u32x4*)((char*)tp + (kt * 64 + lane) * 16) = o; }
            } else {
#pragma unroll
                for (int i = 0; i < 8; ++i) { const int idx = i * 64 + lane, r = idx >> 3, ch = idx & 7; *(LAS u32x4*)(tl + r * 72 + ch * 8) = *(const u32x4*)(tp + r * 64 + ch * 8); }
                asm volatile("s_waitcnt vmcnt(0) lgkmcnt(0)" ::: "memory");
#pragma unroll
                for (int hf = 0; hf < 2; ++hf)
#pragma unroll
                    for (int dp = 0; dp < 2; ++dp) {
                        u32x2 h2[2];
#pragma unroll
                        for (int d2 = 0; d2 < 2; ++d2) { const int dt = dp * 2 + d2; float fv[8];
#pragma unroll
                            for (int j = 0; j < 4; ++j) { fv[j] = bflo((unsigned)tl[(hf * 32 + fq * 4 + j) * 72 + dt * 16 + fr]); fv[4 + j] = bflo((unsigned)tl[(hf * 32 + 16 + fq * 4 + j) * 72 + dt * 16 + fr]); }
                            h2[d2] = pk8_fp8(fv); }
                        u32x4 o; o.x = h2[0].x; o.y = h2[0].y; o.z = h2[1].x; o.w = h2[1].y;
                        *(u32x4*)((char*)tp + ((hf * 2 + dp) * 64 + lane) * 16) = o;
                    }
                asm volatile("s_waitcnt lgkmcnt(0)" ::: "memory");
            }
        }
    }
}

__device__ __forceinline__ void phaseC2(const Prm& p, LAS unsigned char* L, int G) {
    const int tid = threadIdx.x, lane = tid & 63, wave = tid >> 6, fr = lane & 15, fq = lane >> 4;
    unsigned char* ws = p.ws;
    LAS bf16_t* Qs = (LAS bf16_t*)L;
    LAS bf16_t* Ks = (LAS bf16_t*)(L + 33792);
    LAS bf16_t* Ss = (LAS bf16_t*)(L + 67584);
    LAS float* sc = (LAS float*)(L + 76800);
    const bf16_t* MQr = (const bf16_t*)(ws + WS_MQ); const bf16_t* MKr = (const bf16_t*)(ws + WS_MK);
    bf16_t* Qt = (bf16_t*)p.out; bf16_t* KT = Qt + (size_t)M * 1024; bf16_t* SP = (bf16_t*)(ws + WS_SP);
    for (int u = blockIdx.x; u < 1024; u += G) {
        const int bh = u >> 7, c = u & 127, b = bh >> 2, h = bh & 3; const size_t row0 = (size_t)b * T + c * 64; const int s0i = bh * T + c * 64;
        const float* lcf = (const float*)(ws + OFF_LCF); const float* mtv = (const float*)(ws + OFF_MT); const float* liv = (const float*)(ws + OFF_LI);
#pragma unroll
        for (int which = 0; which < 2; ++which) {
            const bf16_t* src = (which ? MKr : MQr) + h * 256 + (tid & 31) * 8; const float* cw = (which ? p.ckw : p.cqw) + h * 256 + (tid & 31) * 8; const float* cb = (which ? p.ckb : p.cqb) + h * 256 + (tid & 31) * 8;
            const float osc = which ? 0.0625f : 1.0f; LAS bf16_t* dstl = which ? Ks : Qs;
            float w0[8], w1[8], w2[8], w3[8], bs[8];
#pragma unroll
            for (int e = 0; e < 8; ++e) { w0[e] = cw[e]; w1[e] = cw[1024 + e]; w2[e] = cw[2048 + e]; w3[e] = cw[3072 + e]; bs[e] = cb[e]; }
#pragma unroll
            for (int i = 0; i < 4; ++i) { const int r = (tid + i * 512) >> 5; const int tt = c * 64 + r;
                u32x4 x0 = {0u, 0u, 0u, 0u}, x1 = x0, x2 = x0; const bf16_t* rp = src + (row0 + r) * 1024;
                if (tt >= 3) x0 = *(const u32x4*)(rp - 3 * 1024);
                if (tt >= 2) x1 = *(const u32x4*)(rp - 2 * 1024);
                if (tt >= 1) x2 = *(const u32x4*)(rp - 1 * 1024);
                const u32x4 x3 = *(const u32x4*)rp;
                float a0[8], a1[8], a2[8], a3[8], o[8]; unpack8(x0, a0); unpack8(x1, a1); unpack8(x2, a2); unpack8(x3, a3);
#pragma unroll
                for (int e = 0; e < 8; ++e) { const float v = bs[e] + w0[e] * a0[e] + w1[e] * a1[e] + w2[e] * a2[e] + w3[e] * a3[e]; o[e] = siluf_(v) * osc; }
                *(LAS u32x4*)(dstl + r * 264 + (tid & 31) * 8) = pack8(o); }
        }
        if (tid < 64) { const float lc = lcf[s0i + tid], mt_ = mtv[s0i + tid], li_ = liv[s0i + tid]; const float lce = lcf[s0i + 63], mte = mtv[s0i + 63];
            sc[tid] = lc; sc[64 + tid] = mt_; sc[128 + tid] = li_; sc[192 + tid] = 0.f; sc[256 + tid] = __expf(lce - lc + li_ - mte);
            if (tid == 0) { const float pF = c ? lcf[s0i - 1] : 0.f, pM = c ? mtv[s0i - 1] : 0.f; sc[320] = pM - pF; sc[321] = mte - lce; } }
        __syncthreads();
        const float Rprev = sc[320];
        {
            const int lt = wave >> 1, st0 = (wave & 1) * 2;
            f32x4 acc[2] = {{0.f, 0.f, 0.f, 0.f}, {0.f, 0.f, 0.f, 0.f}};
#pragma unroll
            for (int ks = 0; ks < 8; ++ks) {
                const bf16x8 a = *(const LAS bf16x8*)(Qs + (lt * 16 + fr) * 264 + ks * 32 + fq * 8);
                const bf16x8 b0 = *(const LAS bf16x8*)(Ks + (st0 * 16 + fr) * 264 + ks * 32 + fq * 8);
                const bf16x8 b1 = *(const LAS bf16x8*)(Ks + ((st0 + 1) * 16 + fr) * 264 + ks * 32 + fq * 8);
                acc[0] = mfma16(a, b0, acc[0]); acc[1] = mfma16(a, b1, acc[1]);
            }
            float rp[4] = {0.f, 0.f, 0.f, 0.f};
#pragma unroll
            for (int i = 0; i < 2; ++i) { const int s = (st0 + i) * 16 + fr; const float cs = sc[128 + s] - sc[s];
#pragma unroll
                for (int j = 0; j < 4; ++j) { const int l = lt * 16 + fq * 4 + j;
                    const float v = (s <= l) ? acc[i][j] * __expf(sc[l] + cs - sc[64 + l]) : 0.f;
                    const unsigned bfv = f2bf(v); Ss[l * 72 + s] = (bf16_t)bfv; rp[j] += bflo(bfv); } }
#pragma unroll
            for (int j = 0; j < 4; ++j) { float v = rp[j]; v += __shfl_xor(v, 1); v += __shfl_xor(v, 2); v += __shfl_xor(v, 4); v += __shfl_xor(v, 8);
                if (fr == 0) atomicAdd((float*)(sc + 192 + lt * 16 + fq * 4 + j), v); }
        }
        __syncthreads();
        {
            { const int r = tid >> 3, ch = tid & 7; *(u32x4*)(SP + (size_t)u * 4096 + r * 64 + ch * 8) = *(const LAS u32x4*)(Ss + r * 72 + ch * 8); }
            if (tid < 64) ((float*)(ws + OFF_RS))[s0i + tid] = sc[192 + tid];
            if (tid == 0) ((float*)(ws + OFF_DEC))[u] = __expf(Rprev - sc[321]);
#pragma unroll
            for (int i = 0; i < 4; ++i) { const int idx = tid + i * 512, r = idx >> 5, ch = idx & 31;
                const float w = __expf(Rprev - (sc[64 + r] - sc[r]));
                float q[8]; unpack8(*(const LAS u32x4*)(Qs + r * 264 + ch * 8), q);
#pragma unroll
                for (int e = 0; e < 8; ++e) q[e] *= w;
                *(u32x4*)(Qt + (row0 + r) * 1024 + h * 256 + ch * 8) = pack8(q); }
            float* kn = (float*)(ws + WS_KN) + (size_t)u * 256;
#pragma unroll
            for (int i = 0; i < 4; ++i) { const int idx = tid + i * 512, d = idx >> 3, scn = idx & 7, s0 = scn * 8;
                float kv[8]; float sum = 0.f; unsigned hb[8];
#pragma unroll
                for (int j = 0; j < 8; ++j) { const float v = bflo((unsigned)Ks[(s0 + j) * 264 + d]) * sc[256 + s0 + j]; hb[j] = f2bf(v); kv[j] = bflo(hb[j]); sum += kv[j]; }
                u32x4 o; o.x = hb[0] | (hb[1] << 16); o.y = hb[2] | (hb[3] << 16); o.z = hb[4] | (hb[5] << 16); o.w = hb[6] | (hb[7] << 16);
                *(u32x4*)(KT + (size_t)u * 16384 + d * 64 + s0) = o;
                sum += __shfl_xor(sum, 1); sum += __shfl_xor(sum, 2); sum += __shfl_xor(sum, 4);
                if (scn == 0) kn[d] = sum; }
        }
        __syncthreads();
    }
}

__device__ __forceinline__ void mlstm_scan(const Prm& p, LAS unsigned char* L) {
    const int tid = threadIdx.x, lane = tid & 63, wave = tid >> 6, fr = lane & 15, fq = lane >> 4;
    unsigned char* ws = p.ws;
    const int mb = blockIdx.x >> 2, bh = mb >> 3, es = mb & 7, b = bh >> 2, h = bh & 3;
    LAS bf16_t* Qs = (LAS bf16_t*)L;
    LAS bf16_t* Ss = (LAS bf16_t*)(L + 33792);
    LAS bf16_t* VTs = (LAS bf16_t*)(L + 43008);
    LAS bf16_t* CTs = (LAS bf16_t*)(L + 47616);
    LAS float* dcs = (LAS float*)(L + 64512);
    const bf16_t* Qt = (const bf16_t*)p.out; const bf16_t* KT = Qt + (size_t)M * 1024; const bf16_t* SP = (const bf16_t*)(ws + WS_SP);
    const bf16_t* MV = (const bf16_t*)(ws + WS_MV); bf16_t* NUM = (bf16_t*)(ws + WS_NUM); const float* dec = (const float*)(ws + OFF_DEC);
    for (int i = tid; i < 32 * 264 / 2; i += NTHR) ((LAS unsigned*)CTs)[i] = 0u;
    if (tid < 128) dcs[tid] = dec[bh * 128 + tid];
    f32x4 acc[2][2];
#pragma unroll
    for (int i = 0; i < 2; ++i)
#pragma unroll
        for (int e = 0; e < 2; ++e) acc[i][e] = (f32x4){0.f, 0.f, 0.f, 0.f};
    u32x4 rqA[4], rsA, rvA, rqB[4], rsB, rvB; bf16x8 kA[4], kB[4], kc[4];
    const int qr[4] = {tid >> 5, (tid + 512) >> 5, (tid + 1024) >> 5, (tid + 1536) >> 5}; const int qch = tid & 31;
    const int sr = tid >> 3, sch = tid & 7;
    const int vr = (tid & 255) >> 2, vch = tid & 3;
#define MS_LOAD(c, X) do { const size_t row0 = (size_t)b * T + (size_t)(c) * 64; const size_t u = (size_t)bh * 128 + (c); \
        _Pragma("unroll") for (int i = 0; i < 4; ++i) rq##X[i] = *(const u32x4*)(Qt + (row0 + qr[i]) * 1024 + h * 256 + qch * 8); \
        _Pragma("unroll") for (int i = 0; i < 2; ++i) _Pragma("unroll") for (int ks = 0; ks < 2; ++ks) k##X[i * 2 + ks] = *(const bf16x8*)(KT + u * 16384 + (size_t)((2 * wave + i) * 16 + fr) * 64 + ks * 32 + fq * 8); \
        rs##X = *(const u32x4*)(SP + u * 4096 + tid * 8); if (tid < 256) rv##X = *(const u32x4*)(MV + (row0 + vr) * 1024 + h * 256 + es * 32 + vch * 8); } while (0)
#define MS_STORE(X) do { \
        _Pragma("unroll") for (int i = 0; i < 4; ++i) { *(LAS u32x4*)(Qs + qr[i] * 264 + qch * 8) = rq##X[i]; kc[i] = k##X[i]; } \
        *(LAS u32x4*)(Ss + sr * 72 + sch * 8) = rs##X; \
        if (tid < 256) { \
        VTs[(vch * 8 + 0) * 72 + vr] = (bf16_t)(rv##X.x & 0xffffu); VTs[(vch * 8 + 1) * 72 + vr] = (bf16_t)(rv##X.x >> 16); VTs[(vch * 8 + 2) * 72 + vr] = (bf16_t)(rv##X.y & 0xffffu); VTs[(vch * 8 + 3) * 72 + vr] = (bf16_t)(rv##X.y >> 16); \
        VTs[(vch * 8 + 4) * 72 + vr] = (bf16_t)(rv##X.z & 0xffffu); VTs[(vch * 8 + 5) * 72 + vr] = (bf16_t)(rv##X.z >> 16); VTs[(vch * 8 + 6) * 72 + vr] = (bf16_t)(rv##X.w & 0xffffu); VTs[(vch * 8 + 7) * 72 + vr] = (bf16_t)(rv##X.w >> 16); } } while (0)
    const int lt = wave >> 1, et = wave & 1;
#define MS_BODY(c, LDSET, STSET) do { \
        const float dc = dcs[(c)]; \
        if ((c) + 2 < 128) MS_LOAD((c) + 2, LDSET); \
        f32x4 na = {0.f, 0.f, 0.f, 0.f}; \
        _Pragma("unroll") for (int ks = 0; ks < 8; ++ks) na = mfma16(*(const LAS bf16x8*)(Qs + (lt * 16 + fr) * 264 + ks * 32 + fq * 8), *(const LAS bf16x8*)(CTs + (et * 16 + fr) * 264 + ks * 32 + fq * 8), na); \
        _Pragma("unroll") for (int ks = 0; ks < 2; ++ks) na = mfma16(*(const LAS bf16x8*)(Ss + (lt * 16 + fr) * 72 + ks * 32 + fq * 8), *(const LAS bf16x8*)(VTs + (et * 16 + fr) * 72 + ks * 32 + fq * 8), na); \
        {   const size_t row0 = (size_t)b * T + (size_t)(c) * 64; \
            _Pragma("unroll") for (int j = 0; j < 4; ++j) NUM[(row0 + lt * 16 + fq * 4 + j) * 1024 + h * 256 + es * 32 + et * 16 + fr] = (bf16_t)f2bf(na[j]); } \
        _Pragma("unroll") for (int i = 0; i < 2; ++i) _Pragma("unroll") for (int e = 0; e < 2; ++e) acc[i][e] *= dc; \
        _Pragma("unroll") for (int ks = 0; ks < 2; ++ks) _Pragma("unroll") for (int e = 0; e < 2; ++e) { const bf16x8 bv = *(const LAS bf16x8*)(VTs + (e * 16 + fr) * 72 + ks * 32 + fq * 8); \
                acc[0][e] = mfma16(kc[ks], bv, acc[0][e]); acc[1][e] = mfma16(kc[2 + ks], bv, acc[1][e]); } \
        __syncthreads(); \
        _Pragma("unroll") for (int i = 0; i < 2; ++i) _Pragma("unroll") for (int e = 0; e < 2; ++e) { u32x2 o; o.x = pk2(acc[i][e][0], acc[i][e][1]); o.y = pk2(acc[i][e][2], acc[i][e][3]); \
                *(LAS u32x2*)(CTs + (e * 16 + fr) * 264 + (2 * wave + i) * 16 + fq * 4) = o; } \
        if ((c) + 1 < 128) MS_STORE(STSET); \
        __syncthreads(); } while (0)
    MS_LOAD(0, A); MS_STORE(A);
    MS_LOAD(1, B);
    __syncthreads();
    for (int c = 0; c < 128; c += 2) {
        MS_BODY(c, A, B);
        MS_BODY(c + 1, B, A);
    }
#undef MS_BODY
#undef MS_LOAD
#undef MS_STORE
}

__device__ __forceinline__ void st_tile(const bf16_t* Kp, const bf16x8 (&qf)[2], int fr, int fq, f32x4 (&st)[4]) {
#pragma unroll
    for (int kt = 0; kt < 4; ++kt) {
        f32x4 a = {0.f, 0.f, 0.f, 0.f};
#pragma unroll
        for (int ks = 0; ks < 2; ++ks) a = mfma16(*(const bf16x8*)(Kp + (size_t)(kt * 16 + fr) * 64 + ks * 32 + fq * 8), qf[ks], a);
        st[kt] = a;
    }
}
__device__ __forceinline__ void pv_tile(const bf16_t* VTp, int vp, const f32x4 (&pr)[4], int fr, int fq, f32x4 (&o)[4]) {
#pragma unroll
    for (int i = 0; i < 2; ++i) {
        u32x4 pw; pw.x = pk2(pr[2 * i][0], pr[2 * i][1]); pw.y = pk2(pr[2 * i][2], pr[2 * i][3]); pw.z = pk2(pr[2 * i + 1][0], pr[2 * i + 1][1]); pw.w = pk2(pr[2 * i + 1][2], pr[2 * i + 1][3]);
        const bf16x8 pb = __builtin_bit_cast(bf16x8, pw);
#pragma unroll
        for (int dt = 0; dt < 4; ++dt) {
            const bf16_t* r = VTp + (size_t)(dt * 16 + fr) * vp + i * 32 + fq * 4;
            const u32x2 lo = *(const u32x2*)r, hi = *(const u32x2*)(r + 16);
            u32x4 vw; vw.x = lo.x; vw.y = lo.y; vw.z = hi.x; vw.w = hi.y;
            o[dt] = mfma16(__builtin_bit_cast(bf16x8, vw), pb, o[dt]);
        }
    }
}
__device__ __forceinline__ void st_tile_frag(const bf16_t* Kt, const bf16x8 (&qf)[2], int lane, f32x4 (&st)[4]) {
#pragma unroll
    for (int kt = 0; kt < 4; ++kt) { f32x4 a = {0.f, 0.f, 0.f, 0.f};
        a = mfma16(*(const bf16x8*)(Kt + ((kt * 2) * 64 + lane) * 8), qf[0], a); a = mfma16(*(const bf16x8*)(Kt + ((kt * 2 + 1) * 64 + lane) * 8), qf[1], a); st[kt] = a; }
}
__device__ __forceinline__ void pv_tile_frag(const bf16_t* Vt, const f32x4 (&pr)[4], int lane, f32x4 (&o)[4]) {
#pragma unroll
    for (int i = 0; i < 2; ++i) {
        u32x4 pw; pw.x = pk2(pr[2 * i][0], pr[2 * i][1]); pw.y = pk2(pr[2 * i][2], pr[2 * i][3]); pw.z = pk2(pr[2 * i + 1][0], pr[2 * i + 1][1]); pw.w = pk2(pr[2 * i + 1][2], pr[2 * i + 1][3]);
        const bf16x8 pb = __builtin_bit_cast(bf16x8, pw);
#pragma unroll
        for (int dt = 0; dt < 4; ++dt) o[dt] = mfma16(*(const bf16x8*)(Vt + ((i * 4 + dt) * 64 + lane) * 8), pb, o[dt]);
    }
}
template <bool FULL>
__device__ __forceinline__ void cmp_p1_tile(f32x4 (&st)[4], int tile, int fq, int nc_col, float& m2, float& l) {
    constexpr float C = 0.125f * 1.4426950408889634f;
    float mx = -1e30f;
#pragma unroll
    for (int kt = 0; kt < 4; ++kt)
#pragma unroll
        for (int j = 0; j < 4; ++j) if (FULL || (tile * 64 + kt * 16 + fq * 4 + j < nc_col)) mx = fmaxf(mx, st[kt][j]);
    mx = fmaxf(mx, __shfl_xor(mx, 16)); mx = fmaxf(mx, __shfl_xor(mx, 32));
    const float mn2 = fmaxf(m2, mx * C); float ps = 0.f;
#pragma unroll
    for (int kt = 0; kt < 4; ++kt)
#pragma unroll
        for (int j = 0; j < 4; ++j) if (FULL || (tile * 64 + kt * 16 + fq * 4 + j < nc_col)) ps += __builtin_amdgcn_exp2f(__builtin_fmaf(st[kt][j], C, -mn2));
    l = l * __builtin_amdgcn_exp2f(m2 - mn2) + ps; m2 = mn2;
}
template <bool FULL>
__device__ __forceinline__ void cmp_p2_tile(f32x4 (&st)[4], int tile, int fq, int nc_col, float off2) {
    constexpr float C = 0.125f * 1.4426950408889634f;
#pragma unroll
    for (int kt = 0; kt < 4; ++kt)
#pragma unroll
        for (int j = 0; j < 4; ++j) st[kt][j] = (FULL || (tile * 64 + kt * 16 + fq * 4 + j < nc_col)) ? __builtin_amdgcn_exp2f(__builtin_fmaf(st[kt][j], C, off2)) : 0.f;
}
__device__ __forceinline__ void online_step(f32x4 (&st)[4], unsigned vmask, float& m, float& l, f32x4 (&o)[4]) {
    float mx = -1e30f;
#pragma unroll
    for (int kt = 0; kt < 4; ++kt)
#pragma unroll
        for (int j = 0; j < 4; ++j) if ((vmask >> (kt * 4 + j)) & 1u) mx = fmaxf(mx, st[kt][j]);
    mx = fmaxf(mx, __shfl_xor(mx, 16)); mx = fmaxf(mx, __shfl_xor(mx, 32));
    const float mn = fmaxf(m, mx); const float alpha = __expf(m - mn);
    float ps = 0.f;
#pragma unroll
    for (int kt = 0; kt < 4; ++kt)
#pragma unroll
        for (int j = 0; j < 4; ++j) { const float pv = ((vmask >> (kt * 4 + j)) & 1u) ? __expf(st[kt][j] - mn) : 0.f; st[kt][j] = pv; ps += pv; }
    ps += __shfl_xor(ps, 16); ps += __shfl_xor(ps, 32);
    l = l * alpha + ps; m = mn;
#pragma unroll
    for (int dt = 0; dt < 4; ++dt) o[dt] *= alpha;
}
__device__ __forceinline__ void load_tile8(const bf16_t* Kt, const bf16_t* Vt, int lane, u32x4 (&k)[4], u32x4 (&v)[4]) {
#pragma unroll
    for (int i = 0; i < 4; ++i) { k[i] = *(const u32x4*)((const char*)Kt + (i * 64 + lane) * 16);
                                  v[i] = *(const u32x4*)((const char*)Vt + (i * 64 + lane) * 16); }
}
template <bool FULL>
__device__ __forceinline__ void tile_step8(const u32x4 (&k)[4], const u32x4 (&v)[4], const u32x2 (&qf)[2], unsigned vm, float& m2, float& l, f32x4 (&o)[4]) {
    constexpr float C = 0.125f * 1.4426950408889634f;
    f32x4 st[4];
#pragma unroll
    for (int kt = 0; kt < 4; ++kt) { f32x4 a = {0.f, 0.f, 0.f, 0.f}; a = mfma8(k[kt].x, k[kt].y, qf[0], a); a = mfma8(k[kt].z, k[kt].w, qf[1], a); st[kt] = a; }
    float mx = -1e30f;
#pragma unroll
    for (int kt = 0; kt < 4; ++kt)
#pragma unroll
        for (int j = 0; j < 4; ++j) if (FULL || ((vm >> (kt * 4 + j)) & 1u)) mx = fmaxf(mx, st[kt][j]);
    mx = fmaxf(mx, __shfl_xor(mx, 16)); mx = fmaxf(mx, __shfl_xor(mx, 32));
    const float mn2 = fmaxf(m2, mx * C); const float alpha = __builtin_amdgcn_exp2f(m2 - mn2); const float off = 8.f - mn2;
    float ps = 0.f;
#pragma unroll
    for (int kt = 0; kt < 4; ++kt)
#pragma unroll
        for (int j = 0; j < 4; ++j) { const float pv = (FULL || ((vm >> (kt * 4 + j)) & 1u)) ? __builtin_amdgcn_exp2f(__builtin_fmaf(st[kt][j], C, off)) : 0.f; st[kt][j] = pv; ps += pv; }
    l = l * alpha + ps; m2 = mn2;
#pragma unroll
    for (int dt = 0; dt < 4; ++dt) o[dt] *= alpha;
#pragma unroll
    for (int hf = 0; hf < 2; ++hf) {
        u32x2 pb; pb.x = pk4_fp8(st[2 * hf][0], st[2 * hf][1], st[2 * hf][2], st[2 * hf][3]); pb.y = pk4_fp8(st[2 * hf + 1][0], st[2 * hf + 1][1], st[2 * hf + 1][2], st[2 * hf + 1][3]);
#pragma unroll
        for (int dp = 0; dp < 2; ++dp) { o[2 * dp] = mfma8(v[hf * 2 + dp].x, v[hf * 2 + dp].y, pb, o[2 * dp]); o[2 * dp + 1] = mfma8(v[hf * 2 + dp].z, v[hf * 2 + dp].w, pb, o[2 * dp + 1]); }
    }
}
__device__ __forceinline__ void tile_step8_dup(const u32x4 (&k)[4], const u32x4 (&v)[4], const u32x2 (&qf)[2], int g, float& m2, float& l, f32x4 (&o)[4]) {
    constexpr float C = 0.125f * 1.4426950408889634f;
    f32x4 st[4];
#pragma unroll
    for (int kt = 0; kt < 4; ++kt) { f32x4 a = {0.f, 0.f, 0.f, 0.f}; a = mfma8(k[kt].x, k[kt].y, qf[0], a); a = mfma8(k[kt].z, k[kt].w, qf[1], a); st[kt] = a; }
    const bool g1 = (g & 1) != 0, g2 = (g & 2) != 0;
    float my[4];
#pragma unroll
    for (int j = 0; j < 4; ++j) { const float lo = g1 ? st[1][j] : st[0][j], hi = g1 ? st[3][j] : st[2][j]; my[j] = g2 ? hi : lo; }
    float mx = fmaxf(fmaxf(my[0], my[1]), fmaxf(my[2], my[3]));
    mx = fmaxf(mx, dpp_f(mx, 2)); mx = fmaxf(mx, dpp_f(mx, 3));
    mx = fmaxf(mx, __shfl_xor(mx, 16)); mx = fmaxf(mx, __shfl_xor(mx, 32));
    const float mn2 = fmaxf(m2, mx * C); const float alpha = __builtin_amdgcn_exp2f(m2 - mn2); const float off = 8.f - mn2;
    float ps = 0.f;
#pragma unroll
    for (int j = 0; j < 4; ++j) { my[j] = __builtin_amdgcn_exp2f(__builtin_fmaf(my[j], C, off)); ps += my[j]; }
    l = l * alpha + ps; m2 = mn2;
#pragma unroll
    for (int dt = 0; dt < 4; ++dt) o[dt] *= alpha;
    const unsigned pk = pk4_fp8(my[0], my[1], my[2], my[3]);
#pragma unroll
    for (int hf = 0; hf < 2; ++hf) {
        u32x2 pb; pb.x = (g == 2 * hf) ? pk : 0u; pb.y = (g == 2 * hf + 1) ? pk : 0u;
#pragma unroll
        for (int dp = 0; dp < 2; ++dp) { o[2 * dp] = mfma8(v[hf * 2 + dp].x, v[hf * 2 + dp].y, pb, o[2 * dp]); o[2 * dp + 1] = mfma8(v[hf * 2 + dp].z, v[hf * 2 + dp].w, pb, o[2 * dp + 1]); }
    }
}
template <class Stream>
__device__ __forceinline__ void attend_stream_dup(int ntiles, const Stream& S, const u32x2 (&qf)[2], int lane, float& m, float& l, f32x4 (&o)[4]) {
    const int g = (lane & 15) >> 2;
    u32x4 k0[4], k1[4], v0[4], v1[4];
    const bf16_t* Kp; const bf16_t* Vp;
    S.addr(0, Kp, Vp); load_tile8(Kp, Vp, lane, k0, v0);
    for (int n = 0; n < ntiles; n += 2) {
        if (n + 1 < ntiles) { S.addr(n + 1, Kp, Vp); load_tile8(Kp, Vp, lane, k1, v1); }
        tile_step8_dup(k0, v0, qf, g, m, l, o);
        if (n + 1 < ntiles) {
            if (n + 2 < ntiles) { S.addr(n + 2, Kp, Vp); load_tile8(Kp, Vp, lane, k0, v0); }
            tile_step8_dup(k1, v1, qf, g, m, l, o);
        }
    }
    l += dpp_f(l, 2); l += dpp_f(l, 3);
#pragma unroll
    for (int dt = 0; dt < 4; ++dt)
#pragma unroll
        for (int j = 0; j < 4; ++j) { float x = o[dt][j]; x += dpp_f(x, 2); x += dpp_f(x, 3); o[dt][j] = x; }
}
struct WinStream {
    const bf16_t* Kb; const bf16_t* Vb; int k00, tcol, t0;
    __device__ __forceinline__ bool full(int n) const { const int k0 = k00 + 64 * n; return (k0 + 63 <= t0) && (t0 + 3 - k0 < 512); }
    __device__ __forceinline__ void addr(int n, const bf16_t*& Kp, const bf16_t*& Vp) const { const size_t o = (size_t)((k00 >> 6) + n) * 4096; Kp = Kb + o; Vp = Vb + o; }
    __device__ __forceinline__ unsigned mask(int n, int fq) const { unsigned vm = 0u; const int k0 = k00 + 64 * n + fq * 4;
#pragma unroll
        for (int kt = 0; kt < 4; ++kt)
#pragma unroll
            for (int j = 0; j < 4; ++j) { const int df = tcol - (k0 + kt * 16 + j); if (df >= 0 && df < 512) vm |= 1u << (kt * 4 + j); }
        return vm; }
};
struct ForcedStream {
    const bf16_t* Kb; const bf16_t* Vb; int nf, cur, tcol;
    __device__ __forceinline__ int blk(int i) const { return i == 0 ? 0 : (i == nf - 1 ? cur : cur - 1); }
    __device__ __forceinline__ bool full(int n) const { return blk(n) < cur; }
    __device__ __forceinline__ void addr(int n, const bf16_t*& Kp, const bf16_t*& Vp) const { const size_t o = (size_t)blk(n) * 4096; Kp = Kb + o; Vp = Vb + o; }
    __device__ __forceinline__ unsigned mask(int n, int fq) const { unsigned vm = 0u; const int k0 = blk(n) * 64 + fq * 4;
#pragma unroll
        for (int kt = 0; kt < 4; ++kt)
#pragma unroll
            for (int j = 0; j < 4; ++j) if (k0 + kt * 16 + j <= tcol) vm |= 1u << (kt * 4 + j);
        return vm; }
};
struct SelStream {
    const bf16_t* Kb; const bf16_t* Vb; int sel, lb, t;
    __device__ __forceinline__ bool full(int) const { return true; }
    __device__ __forceinline__ void addr(int n, const bf16_t*& Kp, const bf16_t*& Vp) const { const size_t o = (size_t)__shfl(sel, lb + n) * 4096; Kp = Kb + o; Vp = Vb + o; }
    __device__ __forceinline__ unsigned mask(int n, int fq) const { unsigned vm = 0u; const int k0 = __shfl(sel, lb + n) * 64 + fq * 4;
#pragma unroll
        for (int kt = 0; kt < 4; ++kt)
#pragma unroll
            for (int j = 0; j < 4; ++j) if (k0 + kt * 16 + j <= t) vm |= 1u << (kt * 4 + j);
        return vm; }
};
template <class Stream>
__device__ __forceinline__ void attend_stream(int ntiles, const Stream& S, const u32x2 (&qf)[2], int lane, float& m, float& l, f32x4 (&o)[4]) {
    const int fq = lane >> 4;
    u32x4 k0[4], k1[4], v0[4], v1[4];
    const bf16_t* Kp; const bf16_t* Vp;
    S.addr(0, Kp, Vp); load_tile8(Kp, Vp, lane, k0, v0);
    for (int n = 0; n < ntiles; n += 2) {
        if (n + 1 < ntiles) { S.addr(n + 1, Kp, Vp); load_tile8(Kp, Vp, lane, k1, v1); }
        if (S.full(n)) tile_step8<true>(k0, v0, qf, 0u, m, l, o); else tile_step8<false>(k0, v0, qf, S.mask(n, fq), m, l, o);
        if (n + 1 < ntiles) {
            if (n + 2 < ntiles) { S.addr(n + 2, Kp, Vp); load_tile8(Kp, Vp, lane, k0, v0); }
            if (S.full(n + 1)) tile_step8<true>(k1, v1, qf, 0u, m, l, o); else tile_step8<false>(k1, v1, qf, S.mask(n + 1, fq), m, l, o);
        }
    }
}
__device__ __forceinline__ void load_q8(const bf16_t* nq, const float* rope, int bt, int head, int fq, u32x2 (&qf)[2]) {
    const bf16_t* qp = nq + (size_t)bt * 512 + head * 64 + fq * 8;
    const u32x4 q0 = *(const u32x4*)qp; const u32x4 q1 = *(const u32x4*)(qp + 32);
    u32x4 ot; ot.x = __shfl_xor(q0.x, 16); ot.y = __shfl_xor(q0.y, 16); ot.z = __shfl_xor(q0.z, 16); ot.w = __shfl_xor(q0.w, 16);
    float a[8], b[8]; unpack8(q0, a); unpack8(q1, b);
    if (fq < 2) {
        const float* tb = rope + (size_t)bt * 16; float oth[8]; unpack8(ot, oth);
        const float sg = fq == 0 ? -1.f : 1.f;
#pragma unroll
        for (int e = 0; e < 8; ++e) a[e] = a[e] * tb[e] + sg * oth[e] * tb[8 + e];
    }
    qf[0] = pk8_fp8(a); qf[1] = pk8_fp8(b);
}
template <bool ROPE>
__device__ __forceinline__ void load_q(const bf16_t* nq, const float* rope, int bt, int head, int fq, bf16x8 (&qf)[2]) {
    const bf16_t* qp = nq + (size_t)bt * 512 + head * 64 + fq * 8;
    u32x4 q0 = *(const u32x4*)qp; const u32x4 q1 = *(const u32x4*)(qp + 32);
    if (ROPE) {
        u32x4 ot; ot.x = __shfl_xor(q0.x, 16); ot.y = __shfl_xor(q0.y, 16); ot.z = __shfl_xor(q0.z, 16); ot.w = __shfl_xor(q0.w, 16);
        if (fq < 2) {
            const float* tb = rope + (size_t)bt * 16; float mine[8], oth[8], r[8]; unpack8(q0, mine); unpack8(ot, oth);
            const float sg = fq == 0 ? -1.f : 1.f;
#pragma unroll
            for (int e = 0; e < 8; ++e) r[e] = mine[e] * tb[e] + sg * oth[e] * tb[8 + e];
            q0 = pack8(r);
        }
    }
    qf[0] = __builtin_bit_cast(bf16x8, q0); qf[1] = __builtin_bit_cast(bf16x8, q1);
}
__device__ __forceinline__ void nsa_unit(const Prm& p, int unit, LAS float* impL, int lane) {
    const int fr = lane & 15, fq = lane >> 4;
    unsigned char* ws = p.ws;
    const int bg = unit >> 11, t0 = (unit & 2047) * 4, b = bg >> 1, g = bg & 1;
    const int qi = fr >> 2, hh = fr & 3, head = g * 4 + hh, tcol = t0 + qi, btcol = b * T + tcol;
    const bf16_t* nq = (const bf16_t*)(ws + WS_NQ); const float* rope = (const float*)(ws + OFF_ROPE);
    const bf16_t* kvrm = (const bf16_t*)(ws + WS_KVRM);
    float g0, g1, g2;
    { const float* gp = (const float*)(ws + WS_GATES) + (size_t)btcol * 32 + 8 + head * 3; const float* bn = p.bng + head * 3;
      g0 = sigmoidf_(gp[0] + bn[0]); g1 = sigmoidf_(gp[1] + bn[1]); g2 = sigmoidf_(gp[2] + bn[2]); }
    f32x4 tot[4];
    {
        bf16x8 qf[2]; load_q<false>(nq, rope, btcol, head, fq, qf);
        const int nc_col = tcol >= 31 ? ((tcol - 31) >> 4) + 1 : 0;
        const int nc_max = (t0 + 3) >= 31 ? ((t0 + 3 - 31) >> 4) + 1 : 0;
        const int ntl = (nc_max + 63) >> 6;
        const bf16_t* Kb = (const bf16_t*)(ws + WS_KC) + (size_t)bg * 512 * 64; const bf16_t* Vb = (const bf16_t*)(ws + WS_VCT) + (size_t)bg * 512 * 64;
        const int nc_t0 = t0 >= 31 ? ((t0 - 31) >> 4) + 1 : 0;
        float m = -1e30f, l = 0.f;
        for (int tile = 0; tile < ntl; ++tile) {
            f32x4 st[4]; st_tile_frag(Kb + (size_t)tile * 4096, qf, lane, st);
            if (tile * 64 + 63 < nc_t0) cmp_p1_tile<true>(st, tile, fq, nc_col, m, l); else cmp_p1_tile<false>(st, tile, fq, nc_col, m, l);
        }
        l += __shfl_xor(l, 16); l += __shfl_xor(l, 32);
        const float off2 = l > 0.f ? -m - __builtin_amdgcn_logf(l) : -1e30f;
        for (int j = lane; j < 1024; j += 64) impL[j] = 0.f;
        LDS_WAIT();
        f32x4 oc[4];
#pragma unroll
        for (int dt = 0; dt < 4; ++dt) oc[dt] = (f32x4){0.f, 0.f, 0.f, 0.f};
        for (int tile = 0; tile < ntl; ++tile) {
            f32x4 st[4]; st_tile_frag(Kb + (size_t)tile * 4096, qf, lane, st);
            if (tile * 64 + 63 < nc_t0) cmp_p2_tile<true>(st, tile, fq, nc_col, off2); else cmp_p2_tile<false>(st, tile, fq, nc_col, off2);
#pragma unroll
            for (int kt = 0; kt < 4; ++kt) {
                float s4 = (st[kt][0] + st[kt][1]) + (st[kt][2] + st[kt][3]); float p3 = st[kt][3];
                s4 += dpp_f(s4, 0); s4 += dpp_f(s4, 1); p3 += dpp_f(p3, 0); p3 += dpp_f(p3, 1);
                if (hh == 0) { impL[qi * 128 + tile * 16 + kt * 4 + fq] = s4; impL[512 + qi * 128 + tile * 16 + kt * 4 + fq] = p3; }
            }
            pv_tile_frag(Vb + (size_t)tile * 4096, st, lane, oc);
        }
#pragma unroll
        for (int dt = 0; dt < 4; ++dt) tot[dt] = oc[dt] * g0;
    }
    LDS_WAIT();
    int selall = 0;
    {
        const int rq = lane >> 4, c = lane & 15, tq = t0 + rq, curq = tq >> 6;
        unsigned key[8];
#pragma unroll
        for (int e = 0; e < 8; ++e) { const int j = e * 16 + c;
            const float iv = impL[rq * 128 + j] + (j > 0 ? impL[512 + rq * 128 + j - 1] : 0.f);
            const bool forced = (j == 0) || (j == curq) || (j == curq - 1), valid = j * 64 <= tq;
            const unsigned rank = forced ? 0x1FFFFFFu : (valid ? ((__builtin_bit_cast(unsigned, fmaxf(iv, 0.f)) >> 7) + 1u) : 0u);
            key[e] = (rank << 7) | (unsigned)(127 - j); }
        for (int n = 0; n < 16; ++n) {
            unsigned lm = key[0];
#pragma unroll
            for (int e = 1; e < 8; ++e) lm = lm > key[e] ? lm : key[e];
            const unsigned rm = row16_max_u32(lm);
            if (c == n) selall = 127 - (int)(rm & 127u);
#pragma unroll
            for (int e = 0; e < 8; ++e) if (key[e] == rm) key[e] = 0u;
        }
    }
    const int nf = (t0 >> 6) == 0 ? 1 : ((t0 >> 6) == 1 ? 2 : 3);
    float ms = -1e30f, ls = 0.f; f32x4 osh[4];
#pragma unroll
    for (int dt = 0; dt < 4; ++dt) osh[dt] = (f32x4){0.f, 0.f, 0.f, 0.f};
    {
        u32x2 qf[2]; load_q8(nq, rope, btcol, head, fq, qf);
        f32x4 ow[4];
#pragma unroll
        for (int dt = 0; dt < 4; ++dt) ow[dt] = (f32x4){0.f, 0.f, 0.f, 0.f};
        float m = -1e30f, l = 0.f;
        const int klo = t0 - 511 > 0 ? t0 - 511 : 0; const int tlo = klo >> 6, thi = (t0 + 3) >> 6;
        WinStream W; W.Kb = kvrm + (size_t)3 * (4 * T * 64) + (size_t)bg * T * 64; W.Vb = kvrm + (size_t)5 * (4 * T * 64) + (size_t)bg * T * 64; W.k00 = tlo * 64; W.tcol = tcol; W.t0 = t0;
        attend_stream(thi - tlo + 1, W, qf, lane, m, l, ow);
        l += __shfl_xor(l, 16); l += __shfl_xor(l, 32);
        const float sc_ = g2 / l;
#pragma unroll
        for (int dt = 0; dt < 4; ++dt) tot[dt] += ow[dt] * sc_;
        ForcedStream F_; F_.Kb = kvrm + (size_t)2 * (4 * T * 64) + (size_t)bg * T * 64; F_.Vb = kvrm + (size_t)4 * (4 * T * 64) + (size_t)bg * T * 64; F_.nf = nf; F_.cur = t0 >> 6; F_.tcol = tcol;
        attend_stream(nf, F_, qf, lane, ms, ls, osh);
    }
    {
#pragma unroll 1
        for (int r = 0; r < 4; ++r) {
            const int t = t0 + r;
            u32x2 qf[2]; load_q8(nq, rope, b * T + t, head, fq, qf);
            f32x4 os[4];
#pragma unroll
            for (int dt = 0; dt < 4; ++dt) os[dt] = (f32x4){0.f, 0.f, 0.f, 0.f};
            float m = -1e30f, l = 0.f;
            SelStream S_; S_.Kb = kvrm + (size_t)2 * (4 * T * 64) + (size_t)bg * T * 64; S_.Vb = kvrm + (size_t)4 * (4 * T * 64) + (size_t)bg * T * 64; S_.sel = selall; S_.lb = r * 16 + nf; S_.t = t;
            const int nv = (t >> 6) + 1 < 16 ? (t >> 6) + 1 : 16;
            if (nv > nf) {
                attend_stream_dup(nv - nf, S_, qf, lane, m, l, os);
                if (qi == r) {
                    const float mn = fmaxf(ms, m), a1 = __builtin_amdgcn_exp2f(ms - mn), a2 = __builtin_amdgcn_exp2f(m - mn);
                    ls = ls * a1 + l * a2; ms = mn;
#pragma unroll
                    for (int dt = 0; dt < 4; ++dt) osh[dt] = osh[dt] * a1 + os[dt] * a2;
                }
            }
        }
        ls += __shfl_xor(ls, 16); ls += __shfl_xor(ls, 32);
        const float scs = g1 / ls;
#pragma unroll
        for (int dt = 0; dt < 4; ++dt) tot[dt] += osh[dt] * scs;
    }
    bf16_t* yn = (bf16_t*)(ws + WS_YN) + (size_t)btcol * 512 + head * 64 + fq * 4;
#pragma unroll
    for (int dt = 0; dt < 4; ++dt) { u32x2 o; o.x = pk2(tot[dt][0], tot[dt][1]); o.y = pk2(tot[dt][2], tot[dt][3]); *(u32x2*)(yn + dt * 16) = o; }
}
__device__ __forceinline__ void phaseC3(const Prm& p, LAS unsigned char* L, int G) {
    const int tid = threadIdx.x, lane = tid & 63, wave = tid >> 6;
    unsigned char* ws = p.ws;
    if (((int)blockIdx.x & 3) == 0 && ((int)blockIdx.x >> 2) < NBM) mlstm_scan(p, L);
    if ((int)blockIdx.x == 1) {
        const int bh = wave; const float* kn = (const float*)(ws + WS_KN); float* np = (float*)(ws + WS_NPREV); const float* dec = (const float*)(ws + OFF_DEC);
        f32x4 n = {0.f, 0.f, 0.f, 0.f};
        for (int c = 0; c < 128; ++c) { const size_t u = (size_t)bh * 128 + c;
            *(f32x4*)(np + u * 256 + lane * 4) = n; const f32x4 k = *(const f32x4*)(kn + u * 256 + lane * 4); n = n * dec[u] + k; }
    }
    LAS float* impL = (LAS float*)(L + wave * 4096);
    unsigned* ctr = (unsigned*)(ws + OFF_CTR);
    const int x0 = (int)blockIdx.x & 7;
    for (int dx = 0; dx < 8; ++dx) {
        const int x = (x0 + dx) & 7;
        for (;;) {
            unsigned u = 0u; if (lane == 0) u = atomicAdd(ctr + x * 8, 1u);
            u = (unsigned)__shfl((int)u, 0);
            if (u >= 1024u) break;
            nsa_unit(p, (x >> 1) * 2048 + 2 * (1023 - (int)u) + (x & 1), impL, lane);
        }
    }
}

__device__ __forceinline__ void phaseC4(const Prm& p, int G) {
    const int tid = threadIdx.x, lane = tid & 63, wave = tid >> 6;
    unsigned char* ws = p.ws;
    const bf16_t* Qt = (const bf16_t*)p.out; bf16_t* NUM = (bf16_t*)(ws + WS_NUM);
    const float* np = (const float*)(ws + WS_NPREV); const float* rs = (const float*)(ws + OFF_RS); const float* mtv = (const float*)(ws + OFF_MT);
    for (int u = blockIdx.x; u < 1024; u += G) {
        const int bh = u >> 7, c = u & 127, b = bh >> 2, h = bh & 3;
        const f32x4 n4 = *(const f32x4*)(np + (size_t)u * 256 + lane * 4); const f32x4 g4 = *(const f32x4*)(p.mhg + h * 256 + lane * 4);
#pragma unroll
        for (int rr = 0; rr < 8; ++rr) {
            const int l = wave * 8 + rr; const size_t row = (size_t)b * T + c * 64 + l; const int si = bh * T + c * 64 + l;
            const u32x2 qw = *(const u32x2*)(Qt + row * 1024 + h * 256 + lane * 4);
            const float dot = wave_sum((bflo(qw.x) * n4[0] + bfhi(qw.x) * n4[1]) + (bflo(qw.y) * n4[2] + bfhi(qw.y) * n4[3]));
            const float den = dot + rs[si]; const float dd = fmaxf(fabsf(den), __expf(-mtv[si])); const float idd = 1.f / dd;
            bf16_t* npnt = NUM + row * 1024 + h * 256 + lane * 4; const u32x2 nw = *(const u32x2*)npnt;
            const float h0 = bflo(nw.x) * idd, h1 = bfhi(nw.x) * idd, h2 = bflo(nw.y) * idd, h3 = bfhi(nw.y) * idd;
            const float mu = wave_sum((h0 + h1) + (h2 + h3)) * (1.f / 256.f);
            const float d0 = h0 - mu, d1 = h1 - mu, d2 = h2 - mu, d3 = h3 - mu;
            const float var = wave_sum((d0 * d0 + d1 * d1) + (d2 * d2 + d3 * d3)) * (1.f / 256.f);
            const float rsd = 1.f / sqrtf(var + EPS);
            u32x2 o; o.x = pk2(d0 * rsd * g4[0], d1 * rsd * g4[1]); o.y = pk2(d2 * rsd * g4[2], d3 * rsd * g4[3]);
            *(u32x2*)npnt = o;
        }
    }
}
__device__ __forceinline__ void phaseG(const Prm& p, int G) {
    const int tid = threadIdx.x, lane = tid & 63, wave = tid >> 6; const int gw = blockIdx.x * NWAVES + wave, NGW = G * NWAVES;
    const float* rowss = (const float*)(p.ws + OFF_RSS16);
#pragma unroll 4
    for (int m = gw; m < M; m += NGW) {
        float ssum = 0.f;
#pragma unroll
        for (int k = 0; k < 16; ++k) ssum += rowss[(size_t)m * 16 + k];
        const float r = 1.f / sqrtf(ssum * (1.f / D) + EPS);
        f32x4* o = (f32x4*)(p.out + (size_t)m * D) + lane; const f32x4* gr = (const f32x4*)p.fng + lane;
#pragma unroll
        for (int j = 0; j < 4; ++j) { const f32x4 v = o[64 * j], g = gr[64 * j]; o[64 * j] = (f32x4){v[0] * r * g[0], v[1] * r * g[1], v[2] * r * g[2], v[3] * r * g[3]}; }
    }
}

#define XB_TMO      128
#define XB_XCNT(j)  (256  + 64 * (j))
#define XB_XSUB(j)  (1280 + 64 * (j))
#define XB_XGEN(j)  (2304 + 64 * (j))
#define XB_TOP      3328
#define XB_TOPGEN   3392
#define XCD_BAR_WORDS 3456
#define XB_SPIN_CAP (1u << 18)

__device__ __forceinline__ unsigned xb_ld(unsigned* p)              { return __hip_atomic_load(p, __ATOMIC_RELAXED, __HIP_MEMORY_SCOPE_AGENT); }
__device__ __forceinline__ unsigned xb_add(unsigned* p, unsigned v) { return __hip_atomic_fetch_add(p, v, __ATOMIC_RELAXED, __HIP_MEMORY_SCOPE_AGENT); }
__device__ __forceinline__ unsigned xb_xcc_id() { return (unsigned)__builtin_amdgcn_s_getreg((3 << 11) | 20) & 0xFu; }
#define XB_SPIN(cond, bar) do { unsigned _sp = 0; while (cond) { __builtin_amdgcn_s_sleep(1); \
    if ((++_sp & 255u) == 0u) { if (xb_ld(&(bar)[XB_TMO])) break; if (_sp > XB_SPIN_CAP) { atomicAdd(&(bar)[XB_TMO], 1u); break; } } } } while (0)

struct XcdBarrier {
    unsigned* bar; unsigned x;
    volatile LAS unsigned* st;
};

__device__ __forceinline__ XcdBarrier xcd_barrier_post(unsigned* bar, volatile LAS unsigned* st) {
    XcdBarrier b; b.bar = bar; b.x = xb_xcc_id(); b.st = st;
    if (threadIdx.x == 0) (void)xb_add(&bar[XB_XCNT(b.x)], 1u);
    return b;
}
__device__ __forceinline__ void xcd_barrier_complete(unsigned* bar, unsigned x, unsigned& nloc, unsigned& nx) {
    const unsigned G = gridDim.x * gridDim.y * gridDim.z;
    unsigned sum, cnt, mine, sp = 0u;
    for (;;) {
        sum = 0u; cnt = 0u; mine = 0u;
#pragma unroll
        for (unsigned j = 0; j < 16; ++j) { const unsigned c = xb_ld(&bar[XB_XCNT(j)]); sum += c; cnt += (c > 0u) ? 1u : 0u; mine = (j == x) ? c : mine; }
        if (sum == G) break;
        __builtin_amdgcn_s_sleep(1);
        if ((++sp & 255u) == 0u) { if (xb_ld(&bar[XB_TMO])) break; if (sp > XB_SPIN_CAP) { atomicAdd(&bar[XB_TMO], 1u); break; } }
    }
    nloc = mine > 0u ? mine : 1u; nx = cnt > 0u ? cnt : 1u;
}

__device__ __forceinline__ void xcd_barrier(const XcdBarrier& b) {
    asm volatile("s_waitcnt vmcnt(0)" ::: "memory");
    __syncthreads();
    if (threadIdx.x == 0) {
        unsigned* bar = b.bar;
        __builtin_amdgcn_s_waitcnt(0);
        unsigned nloc = b.st[0], nx = b.st[1];
        if (nloc == 0u) { xcd_barrier_complete(bar, b.x, nloc, nx); b.st[0] = nloc; b.st[1] = nx; }
        const unsigned old = xb_add(&bar[XB_XSUB(b.x)], 1u);
        const unsigned gen = old / nloc;
        if (old + 1u == (gen + 1u) * nloc) {
            __builtin_amdgcn_fence(__ATOMIC_RELEASE, "agent");
            asm volatile("s_waitcnt vmcnt(0)" ::: "memory");
            const unsigned og = xb_add(&bar[XB_TOP], 1u);
            const unsigned tg = og / nx;
            if (og + 1u == (tg + 1u) * nx) xb_add(&bar[XB_TOPGEN], 1u);
            else XB_SPIN(xb_ld(&bar[XB_TOPGEN]) == tg, bar);
            __builtin_amdgcn_fence(__ATOMIC_ACQUIRE, "agent");
            xb_add(&bar[XB_XGEN(b.x)], 1u);
            asm volatile("s_waitcnt vmcnt(0)" ::: "memory");
        } else {
            XB_SPIN(xb_ld(&bar[XB_XGEN(b.x)]) == gen, bar);
            __builtin_amdgcn_fence(__ATOMIC_ACQUIRE, "agent");
            asm volatile("s_waitcnt vmcnt(0)" ::: "memory");
        }
    }
    __syncthreads();
}

constexpr int N_PHASES = 11;
__global__ void __launch_bounds__(NTHR, 2) fwd_kernel(Prm p) {
    extern __shared__ __attribute__((aligned(16))) unsigned char lds[];
    LAS unsigned char* L = (LAS unsigned char*)lds;
    const int G = gridDim.x;
    unsigned char* ws = p.ws;
    const int lo = p.ph_lo, hi = p.ph_hi;
    volatile LAS unsigned* bst = (volatile LAS unsigned*)(L + 135168);
    if (threadIdx.x < 2) bst[threadIdx.x] = 0u;
    __syncthreads();
    XcdBarrier bar; bar.bar = (unsigned*)(ws + OFF_BAR); bar.x = 0; bar.st = nullptr;
    if (p.coop) bar = xcd_barrier_post((unsigned*)(ws + OFF_BAR), bst);
#define IN(k) (lo <= (k) && (k) < hi)
#define SEAM(k) do { if (p.coop && IN((k) + 1)) { xcd_barrier(bar); } } while (0)
    if (IN(0)) { phaseA(p, L, G); SEAM(0); }
    if (IN(1)) {
        pg8::Gemm g{(const bf16_t*)(ws + WS_XN), (const bf16_t*)(ws + WS_WIN), M, N1, D}; pg8::StaticOrder S; S.init(M, N1, G, (int)blockIdx.x);
        EpiP1 E{(bf16_t*)(ws + WS_MQ), (bf16_t*)(ws + WS_NQ), (bf16_t*)(ws + WS_KVRM), (bf16_t*)(ws + WS_VT), (float*)(ws + WS_GATES)};
        pg8::gemm_phase<EpiP1, pg8::StaticOrder, true, true>(L, g, S, E);
        deferred_weights(p, L, G);
        SEAM(1);
    }
    if (IN(2)) { phaseC1(p, L, G); SEAM(2); }
    if (IN(3)) { phaseC2(p, L, G); SEAM(3); }
    if (IN(4)) { phaseC3(p, L, G); SEAM(4); }
    if (IN(5)) { phaseC4(p, G); SEAM(5); }
    if (IN(6)) {
        pg8::Gemm g{(const bf16_t*)(ws + WS_XN), (const bf16_t*)(ws + WS_WIN) + (size_t)N1 * D, M, N2, D}; pg8::StaticOrder S; S.init(M, N2, G, (int)blockIdx.x);
        EpiP2 E{(bf16_t*)(ws + WS_NUM), (bf16_t*)(ws + WS_YN), (bf16_t*)(ws + WS_MQ), (bf16_t*)(ws + WS_MK)};
        pg8::gemm_phase<EpiP2, pg8::StaticOrder, true, true>(L, g, S, E);
        SEAM(6);
    }
    if (IN(7)) {
        pg8::Gemm g{(const bf16_t*)(ws + WS_NUM), (const bf16_t*)(ws + WS_WA), M, D, D}; pg8::StaticOrder S; S.init(M, D, G, (int)blockIdx.x);
        EpiE1 E{(const bf16_t*)(ws + WS_MQ), (bf16_t*)p.out};
        pg8::gemm_phase<EpiE1, pg8::StaticOrder, true, true>(L, g, S, E);
    }
    if (IN(8)) {
        pg8::Gemm g{(const bf16_t*)(ws + WS_YN), (const bf16_t*)(ws + WS_WB), M, D, 512}; pg8::StaticOrder S; S.init(M, D, G, (int)blockIdx.x);
        EpiE2 E{(const bf16_t*)(ws + WS_MK), (const bf16_t*)p.out, (bf16_t*)(ws + WS_XN)};
        pg8::gemm_phase<EpiE2, pg8::StaticOrder, true, true>(L, g, S, E);
        SEAM(8);
    }
    if (IN(9)) {
        pg8::Gemm g{(const bf16_t*)(ws + WS_XN), (const bf16_t*)(ws + WS_WO), M, D, D}; pg8::StaticOrder S; S.init(M, D, G, (int)blockIdx.x);
        EpiFN E{p.x, p.out, p.fng, (float*)(ws + OFF_RSS16), (unsigned*)(ws + OFF_BAR + 14 * KiB)};
        pg8::gemm_phase<EpiFN, pg8::StaticOrder, false, true>(L, g, S, E);
    }
#undef IN
#undef SEAM
}

#ifndef MK_COOP
#define MK_COOP 1
#endif
extern "C" void kernel_launch(void* const* d_in, const int* in_sizes, int n_in, void* d_out, int out_size, void* d_ws, size_t ws_size, hipStream_t stream) {
    static int grid = 0;
    if (grid == 0) {
        int dev = 0, cus = 0, per_cu = 0;
        if (n_in != 22 || ws_size < WS_END) { fprintf(stderr, "kernel_launch: unexpected n_in %d / ws %zu\n", n_in, ws_size); grid = -1; return; }
        (void)hipGetDevice(&dev); (void)hipDeviceGetAttribute(&cus, hipDeviceAttributeMultiprocessorCount, dev);
        if (hipFuncSetAttribute((const void*)fwd_kernel, hipFuncAttributeMaxDynamicSharedMemorySize, LDS_BYTES) != hipSuccess) { fprintf(stderr, "kernel_launch: hipFuncSetAttribute failed\n"); grid = -1; return; }
        if (hipOccupancyMaxActiveBlocksPerMultiprocessor(&per_cu, (const void*)fwd_kernel, NTHR, LDS_BYTES) != hipSuccess || per_cu < 1) { fprintf(stderr, "kernel_launch: occupancy query gave %d\n", per_cu); per_cu = 1; }
        (void)hipGetLastError();
        grid = cus * (per_cu > 1 ? 1 : per_cu);
        if (grid < NBM * 4) { fprintf(stderr, "kernel_launch: grid %d too small\n", grid); grid = -1; return; }
    }
    if (grid < 0) return;
    Prm p{};
    p.x = (const float*)d_in[0]; p.pos = (const int*)d_in[1]; p.norm_g = (const float*)d_in[2]; p.w_in = (const float*)d_in[3];
    p.cqw = (const float*)d_in[4]; p.cqb = (const float*)d_in[5]; p.ckw = (const float*)d_in[6]; p.ckb = (const float*)d_in[7];
    p.big = (const float*)d_in[8]; p.bfg = (const float*)d_in[9]; p.mhg = (const float*)d_in[10];
    p.cpk = (const float*)d_in[11]; p.cw1k = (const float*)d_in[12]; p.cw2k = (const float*)d_in[13];
    p.cpv = (const float*)d_in[14]; p.cw1v = (const float*)d_in[15]; p.cw2v = (const float*)d_in[16];
    p.bng = (const float*)d_in[17]; p.wa = (const float*)d_in[18]; p.wb = (const float*)d_in[19]; p.wo = (const float*)d_in[20]; p.fng = (const float*)d_in[21];
    p.out = (float*)d_out; p.ws = (unsigned char*)d_ws;
#if MK_COOP
    (void)hipMemsetAsync((char*)d_ws + OFF_BAR, 0, 16 * KiB, stream);
    p.ph_lo = 0; p.ph_hi = N_PHASES; p.coop = 1; p.pad = 0;
    void* args[] = {&p};
    hipError_t e = hipLaunchCooperativeKernel((const void*)fwd_kernel, dim3(grid), dim3(NTHR), args, LDS_BYTES, stream);
    if (e != hipSuccess) fprintf(stderr, "kernel_launch: cooperative launch failed: %s (grid %d)\n", hipGetErrorString(e), grid);
#else
    for (int ph = 0; ph < N_PHASES; ++ph) {
        p.ph_lo = ph; p.ph_hi = ph + 1; p.coop = 0; p.pad = 0;
        hipLaunchKernelGGL(fwd_kernel, dim3(grid), dim3(NTHR), LDS_BYTES, stream, p);
    }
#endif
}
```

```cpp
#include <hip/hip_runtime.h>
#include <hip/hip_cooperative_groups.h>
#include <cstdio>
#include <cstdint>
namespace cg = cooperative_groups;
namespace pg8 {
#define PG8_LAS __attribute__((address_space(3)))
typedef unsigned short bf16_t;
typedef short bf16x8 __attribute__((ext_vector_type(8)));
typedef float f32x4 __attribute__((ext_vector_type(4)));
typedef unsigned u32x4 __attribute__((ext_vector_type(4)));
constexpr int BM = 256, BK = 64, HALF = 128, HTB = HALF * BK * 2  , STAGE_BYTES = 8 * HTB, NXCD = 8, WGM = 8;

__host__ __device__ __forceinline__ int lds_byte(int r, int c) { const int st = (r >> 4) * 2 + (c >> 5), rr = r & 15, cc = c & 31, ob = rr * 64 + cc * 2; return st * 1024 + (ob ^ (((ob >> 9) & 1) << 5)); }
__host__ __device__ __forceinline__ void stage_rc(int b, int& R, int& C) { const int st = b / 1024, sb = b % 1024, swz = sb ^ (((sb >> 9) & 1) << 5); R = (st >> 1) * 16 + swz / 64; C = (st & 1) * 32 + (swz % 64) / 2; }
__host__ __device__ __forceinline__ int perm32(int rho) { const int n = rho >> 4, i = rho & 15; return 8 * (i >> 2) + 4 * n + (i & 3); }

struct Unit { int pm, pn; };
struct Gemm { const bf16_t* A; const bf16_t* Bt; int M, N, K; };

struct StaticOrder {
    int nM, nN, nwg, G, c;
    __host__ __device__ void init(int M, int N, int G_, int c_) { nM = M / BM; nN = N / BM; nwg = nM * nN; G = G_; c = c_; }
    __host__ __device__ bool next(int i, Unit& u) const {
        const long L = (long)i * G + c; if (L >= nwg) return false;
        int wgid = (int)L; { const int q = nwg / NXCD, r = nwg % NXCD, xcd = wgid % NXCD, off = wgid / NXCD; wgid = (xcd < r ? xcd * (q + 1) : r * (q + 1) + (xcd - r) * q) + off; }
        const int nig = WGM * nN, gid = wgid / nig, fm = gid * WGM, gsz = (nM - fm) < WGM ? (nM - fm) : WGM;
        u.pm = fm + ((wgid % nig) % gsz); u.pn = (wgid % nig) / gsz; return true;
    }
    __device__ __forceinline__ void a_ready(const Unit&) const {}
    __device__ __forceinline__ void done(const Unit&) const {}
};

__device__ __forceinline__ unsigned cvt_pk_bf16(float lo, float hi) { unsigned r; asm volatile("v_cvt_pk_bf16_f32 %0, %1, %2" : "=v"(r) : "v"(lo), "v"(hi)); return r; }
template <class Epi, class Sched, bool ALIGN_EPI = false, bool SP2 = false>
__device__ __forceinline__ void gemm_phase(PG8_LAS unsigned char* lds, const Gemm g, const Sched& S, const Epi& E) {
    const int tid = threadIdx.x, wid = __builtin_amdgcn_readfirstlane(tid >> 6), lane = tid & 63, wr = wid >> 2, wc = wid & 3, fr = lane & 15, fq = lane >> 4;
    const int K = g.K, nt = K / BK;
    unsigned voffA[2], voffB[2];
#pragma unroll
    for (int i = 0; i < 2; ++i) { int R, C; stage_rc(tid * 16 + i * 8192, R, C); const int Rb = Epi::PERM ? ((R & ~31) + perm32(R & 31)) : R;
        voffA[i] = (unsigned)(R * K + C) * 2u; voffB[i] = (unsigned)(Rb * K + C) * 2u; }
    const size_t kstep = (size_t)(BK * 2);
    const size_t hstep = (size_t)HALF * K * 2;
    const size_t tstep = 2 * hstep;
    const unsigned ldsw = (unsigned)wid * 1024u;
    const int aoff = lds_byte(wr * 64 + fr, fq * 8), boff = lds_byte(wc * 32 + fr, fq * 8);
#define PG8_SA(b, h) (((b) * 2 + (h)) * HTB)
#define PG8_SB(b, h) ((4 + (b) * 2 + (h)) * HTB)
#define PG8_STAGE(bufoff, gbase, voff) do { _Pragma("unroll") for (int _i = 0; _i < 2; ++_i) \
        __builtin_amdgcn_global_load_lds((const unsigned*)((const char*)(gbase) + (voff)[_i]), (PG8_LAS unsigned*)(lds + (bufoff) + ldsw + _i * 8192), 16, 0, 0); } while (0)
#define PG8_LDA(dst, b, h) do { _Pragma("unroll") for (int m = 0; m < 4; ++m) _Pragma("unroll") for (int k = 0; k < 2; ++k) dst[m][k] = *(const PG8_LAS bf16x8*)(lds + PG8_SA(b, h) + aoff + m * 2048 + k * 1024); } while (0)
#define PG8_LDB(dst, b, h) do { _Pragma("unroll") for (int n = 0; n < 2; ++n) _Pragma("unroll") for (int k = 0; k < 2; ++k) dst[n][k] = *(const PG8_LAS bf16x8*)(lds + PG8_SB(b, h) + boff + n * 2048 + k * 1024); } while (0)
#define PG8_MMA(ai, bj, At, Bt) do { __builtin_amdgcn_s_setprio(1); _Pragma("unroll") for (int m = 0; m < 4; ++m) _Pragma("unroll") for (int n = 0; n < 2; ++n) _Pragma("unroll") for (int k = 0; k < 2; ++k) \
        acc[ai][bj][m][n] = __builtin_amdgcn_mfma_f32_16x16x32_bf16(Bt[n][k], At[m][k], acc[ai][bj][m][n], 0, 0, 0); __builtin_amdgcn_s_setprio(0); } while (0)
#define PG8_WAIT_V(n) asm volatile("s_waitcnt vmcnt(" #n ")" ::: "memory")
#define PG8_WAIT_L(n) asm volatile("s_waitcnt lgkmcnt(" #n ")" ::: "memory")
#define PG8_BAR __builtin_amdgcn_s_barrier()
#define PG8_SCHED __builtin_amdgcn_sched_barrier(0)
    Unit cur, nxt; int ui = 0;
    if (!S.next(0, cur)) return;
    f32x4 acc[2][2][4][2];
#pragma unroll
    for (int a = 0; a < 2; ++a)
#pragma unroll
        for (int b = 0; b < 2; ++b)
#pragma unroll
            for (int m = 0; m < 4; ++m)
#pragma unroll
                for (int n = 0; n < 2; ++n) acc[a][b][m][n] = (f32x4){0.f, 0.f, 0.f, 0.f};
    bf16x8 At[4][2], B0[2][2], B1[2][2];
    const char* cA = (const char*)g.A + (size_t)cur.pm * tstep; const char* cB = (const char*)g.Bt + (size_t)cur.pn * tstep;
    S.a_ready(cur);
    if constexpr (SP2) {
        PG8_STAGE(PG8_SB(0, 0), cB, voffB); PG8_STAGE(PG8_SB(0, 1), cB + hstep, voffB); PG8_STAGE(PG8_SA(0, 0), cA, voffA); PG8_STAGE(PG8_SA(0, 1), cA + hstep, voffA);
        if (wr == 1) PG8_BAR;
        PG8_WAIT_V(2); PG8_BAR;
        PG8_STAGE(PG8_SB(1, 0), cB + kstep, voffB); PG8_STAGE(PG8_SA(1, 0), cA + kstep, voffA); PG8_STAGE(PG8_SB(1, 1), cB + hstep + kstep, voffB);
        PG8_WAIT_V(6); PG8_BAR;
    } else {
        PG8_STAGE(PG8_SB(0, 0), cB, voffB); PG8_STAGE(PG8_SA(0, 0), cA, voffA); PG8_STAGE(PG8_SB(0, 1), cB + hstep, voffB); PG8_STAGE(PG8_SA(0, 1), cA + hstep, voffA);
        if (wr == 1) PG8_BAR;
        PG8_WAIT_V(4); PG8_BAR;
        PG8_STAGE(PG8_SB(1, 0), cB + kstep, voffB); PG8_STAGE(PG8_SA(1, 0), cA + kstep, voffA); PG8_STAGE(PG8_SB(1, 1), cB + hstep + kstep, voffB);
        PG8_WAIT_V(6); PG8_BAR;
    }
    for (;;) {
        const bool has_next = S.next(ui + 1, nxt);
        const char* nA = has_next ? (const char*)g.A + (size_t)nxt.pm * tstep : cA; const char* nB = has_next ? (const char*)g.Bt + (size_t)nxt.pn * tstep : cB;
        for (int t = 0; t < nt; t += 2) {
            const bool last = (t == nt - 2);
            const char* a1 = cA + (size_t)(t + 1) * kstep;
            const char* a2 = last ? nA : cA + (size_t)(t + 2) * kstep; const char* b2 = last ? nB : cB + (size_t)(t + 2) * kstep;
            const char* a3 = a2 + kstep; const char* b3 = b2 + kstep;
            if (last && has_next) S.a_ready(nxt);
            if constexpr (SP2) {
            PG8_LDB(B0, 0, 0); PG8_LDB(B1, 0, 1); PG8_SCHED; PG8_LDA(At, 0, 0); PG8_STAGE(PG8_SA(1, 1), a1 + hstep, voffA);
            PG8_WAIT_V(8); PG8_WAIT_L(0); PG8_BAR; PG8_MMA(0, 0, At, B0); PG8_MMA(0, 1, At, B1); PG8_BAR; PG8_SCHED;
            PG8_LDA(At, 0, 1); PG8_STAGE(PG8_SB(0, 0), b2, voffB); PG8_STAGE(PG8_SB(0, 1), b2 + hstep, voffB); PG8_STAGE(PG8_SA(0, 0), a2, voffA);
            PG8_WAIT_V(8); PG8_WAIT_L(0); PG8_BAR; PG8_MMA(1, 0, At, B0); PG8_MMA(1, 1, At, B1); PG8_BAR; PG8_SCHED;
            PG8_LDB(B0, 1, 0); PG8_LDB(B1, 1, 1); PG8_SCHED; PG8_LDA(At, 1, 0); PG8_STAGE(PG8_SA(0, 1), a2 + hstep, voffA);
            PG8_WAIT_V(8); PG8_WAIT_L(0); PG8_BAR; PG8_MMA(0, 0, At, B0); PG8_MMA(0, 1, At, B1); PG8_BAR; PG8_SCHED;
            PG8_LDA(At, 1, 1); PG8_STAGE(PG8_SB(1, 0), b3, voffB); PG8_STAGE(PG8_SB(1, 1), b3 + hstep, voffB); PG8_STAGE(PG8_SA(1, 0), a3, voffA);
            PG8_WAIT_V(8); PG8_WAIT_L(0); PG8_BAR; PG8_MMA(1, 0, At, B0); PG8_MMA(1, 1, At, B1); PG8_BAR; PG8_SCHED;
            } else {
            PG8_LDB(B0, 0, 0); PG8_SCHED; PG8_LDA(At, 0, 0); PG8_STAGE(PG8_SA(1, 1), a1 + hstep, voffA);
            PG8_WAIT_L(8); PG8_BAR; PG8_WAIT_L(0); PG8_MMA(0, 0, At, B0); PG8_BAR; PG8_SCHED;
            PG8_LDB(B1, 0, 1); PG8_STAGE(PG8_SB(0, 0), b2, voffB);
            PG8_BAR; PG8_WAIT_L(0); PG8_MMA(0, 1, At, B1); PG8_BAR;
            PG8_LDA(At, 0, 1); PG8_STAGE(PG8_SA(0, 0), a2, voffA);
            PG8_BAR; PG8_WAIT_L(0); PG8_MMA(1, 0, At, B0); PG8_BAR; PG8_SCHED;
            PG8_STAGE(PG8_SB(0, 1), b2 + hstep, voffB);
            PG8_WAIT_V(6); PG8_BAR; PG8_MMA(1, 1, At, B1); PG8_BAR;
            PG8_LDB(B0, 1, 0); PG8_SCHED; PG8_LDA(At, 1, 0); PG8_STAGE(PG8_SA(0, 1), a2 + hstep, voffA);
            PG8_WAIT_L(8); PG8_BAR; PG8_WAIT_L(0); PG8_MMA(0, 0, At, B0); PG8_BAR; PG8_SCHED;
            PG8_LDB(B1, 1, 1); PG8_STAGE(PG8_SB(1, 0), b3, voffB);
            PG8_BAR; PG8_WAIT_L(0); PG8_MMA(0, 1, At, B1); PG8_BAR;
            PG8_LDA(At, 1, 1); PG8_STAGE(PG8_SA(1, 0), a3, voffA);
            PG8_BAR; PG8_WAIT_L(0); PG8_MMA(1, 0, At, B0); PG8_BAR; PG8_SCHED;
            PG8_STAGE(PG8_SB(1, 1), b3 + hstep, voffB);
            PG8_WAIT_V(6); PG8_BAR; PG8_MMA(1, 1, At, B1); PG8_BAR;
            }
        }
        if constexpr (ALIGN_EPI) { if (wr == 0) PG8_BAR; }
        if constexpr (!Epi::AFTER_DRAIN) { E(acc, cur, wr, wc, fr, fq); S.done(cur); }
        if (!has_next) break;
#pragma unroll
        for (int a = 0; a < 2; ++a)
#pragma unroll
            for (int b = 0; b < 2; ++b)
#pragma unroll
                for (int m = 0; m < 4; ++m)
#pragma unroll
                    for (int n = 0; n < 2; ++n) acc[a][b][m][n] = (f32x4){0.f, 0.f, 0.f, 0.f};
        cur = nxt; cA = nA; cB = nB; ++ui;
        if constexpr (ALIGN_EPI) { if (wr == 1) PG8_BAR; }
    }
    PG8_WAIT_V(0);
    if constexpr (!ALIGN_EPI) { if (wr == 0) PG8_BAR; }
    PG8_BAR;
    if constexpr (Epi::AFTER_DRAIN) { E.fused(acc, cur, wr, wc, fr, fq, lds, wid, lane); S.done(cur); }
#undef PG8_SA
#undef PG8_SB
#undef PG8_STAGE
#undef PG8_LDA
#undef PG8_LDB
#undef PG8_MMA
#undef PG8_WAIT_V
#undef PG8_WAIT_L
#undef PG8_BAR
#undef PG8_SCHED
}
}

#define LAS __attribute__((address_space(3)))
using pg8::bf16_t; using pg8::bf16x8; using pg8::f32x4; using pg8::u32x4;
typedef short bf16x4 __attribute__((ext_vector_type(4)));
typedef unsigned u32x2 __attribute__((ext_vector_type(2)));
constexpr int BATCH = 2, T = 8192, D = 1024, M = BATCH * T;
constexpr int N1 = 4608, N2 = 4608, INW = 8992;
constexpr float EPS = 1e-6f;
constexpr int NTHR = 512, NWAVES = 8;
constexpr int LDS_BYTES = 147456;
constexpr int MLSTM_E = 32, NBM = 8 * (256 / MLSTM_E);

constexpr size_t MiB = 1u << 20, KiB = 1u << 10;
constexpr size_t OFF_ROWSS = 0, OFF_LCF = 64 * KiB, OFF_MT = 320 * KiB, OFF_LI = 576 * KiB, OFF_RS = 832 * KiB, OFF_DEC = 1088 * KiB, OFF_CTR = 1096 * KiB, OFF_BAR = 1104 * KiB  , OFF_ROPE = 2 * MiB, OFF_RSS16 = 3 * MiB;
constexpr size_t WS_KN = 4 * MiB, WS_NPREV = 5 * MiB, WS_KC = 6 * MiB, WS_VCT = 6 * MiB + 256 * KiB, WS_W1KT = 6 * MiB + 512 * KiB, WS_W1VT = 7 * MiB,
                 WS_W2KT = 7 * MiB + 512 * KiB, WS_W2VT = 7 * MiB + 528 * KiB, WS_GATES = 8 * MiB, WS_WA = 10 * MiB, WS_WO = 12 * MiB, WS_WB = 14 * MiB,
                 WS_WIN = 16 * MiB, WS_SP = 16 * MiB  , WS_XN = 34 * MiB, WS_MQ = 66 * MiB, WS_MK = 98 * MiB, WS_MV = 130 * MiB,
                 WS_NQ = 162 * MiB, WS_KVRM = 178 * MiB, WS_VT = 194 * MiB, WS_NUM = 202 * MiB, WS_YN = 234 * MiB, WS_END = 250 * MiB;

struct Prm {
    const float* x; const int* pos; const float *norm_g, *w_in, *cqw, *cqb, *ckw, *ckb, *big, *bfg, *mhg, *cpk, *cw1k, *cw2k, *cpv, *cw1v, *cw2v, *bng, *wa, *wb, *wo, *fng;
    float* out; unsigned char* ws;
    int ph_lo, ph_hi, coop, pad;
};

__device__ __forceinline__ unsigned f2bf(float f) { unsigned u = __builtin_bit_cast(unsigned, f); return (u + 0x7fffu + ((u >> 16) & 1u)) >> 16; }
__device__ __forceinline__ float bflo(unsigned w) { return __builtin_bit_cast(float, w << 16); }
__device__ __forceinline__ float bfhi(unsigned w) { return __builtin_bit_cast(float, w & 0xffff0000u); }
typedef __bf16 bf16v2_t __attribute__((ext_vector_type(2)));
typedef float f32v2_t __attribute__((ext_vector_type(2)));
__device__ __forceinline__ unsigned pk2(float lo, float hi) { const f32v2_t f = {lo, hi}; const bf16v2_t r = __builtin_convertvector(f, bf16v2_t); return __builtin_bit_cast(unsigned, r); }
__device__ __forceinline__ float sigmoidf_(float v) { return 1.f / (1.f + __expf(-v)); }
__device__ __forceinline__ float siluf_(float v) { return v / (1.f + __expf(-v)); }
#define DPP_I(v, ctrl) __builtin_amdgcn_update_dpp(0, (int)(v), (ctrl), 0xF, 0xF, true)
__device__ __forceinline__ float dpp_f(float v, const int ctrl_sel) {
    const int i = __builtin_bit_cast(int, v);
    const int r = ctrl_sel == 0 ? DPP_I(i, 0xB1) : (ctrl_sel == 1 ? DPP_I(i, 0x4E) : (ctrl_sel == 2 ? DPP_I(i, 0x124) : DPP_I(i, 0x128)));
    return __builtin_bit_cast(float, r);
}
__device__ __forceinline__ float wave_sum(float v) {
    v += dpp_f(v, 0); v += dpp_f(v, 1); v += dpp_f(v, 2); v += dpp_f(v, 3);
    v += __shfl_xor(v, 16); v += __shfl_xor(v, 32);
    return v;
}
__device__ __forceinline__ float wave_max(float v) {
#pragma unroll
    for (int o = 1; o < 64; o <<= 1) v = fmaxf(v, __shfl_xor(v, o));
    return v;
}
#define LDS_WAIT() asm volatile("s_waitcnt lgkmcnt(0)" ::: "memory")
__device__ __forceinline__ f32x4 mfma16(bf16x8 a, bf16x8 b, f32x4 c) { return __builtin_amdgcn_mfma_f32_16x16x32_bf16(a, b, c, 0, 0, 0); }
__device__ __forceinline__ void unpack8(u32x4 w, float (&f)[8]) {
    f[0] = bflo(w.x); f[1] = bfhi(w.x); f[2] = bflo(w.y); f[3] = bfhi(w.y); f[4] = bflo(w.z); f[5] = bfhi(w.z); f[6] = bflo(w.w); f[7] = bfhi(w.w);
}
__device__ __forceinline__ u32x4 pack8(const float (&f)[8]) { u32x4 w; w.x = pk2(f[0], f[1]); w.y = pk2(f[2], f[3]); w.z = pk2(f[4], f[5]); w.w = pk2(f[6], f[7]); return w; }

__device__ __forceinline__ unsigned row16_max_u32(unsigned v) {
    unsigned t;
    t = (unsigned)DPP_I(v, 0xB1); v = v > t ? v : t;
    t = (unsigned)DPP_I(v, 0x4E); v = v > t ? v : t;
    t = (unsigned)DPP_I(v, 0x124); v = v > t ? v : t;
    t = (unsigned)DPP_I(v, 0x128); v = v > t ? v : t;
    return v;
}
typedef unsigned long long u64_t;
__device__ __forceinline__ unsigned pk4_fp8(float a, float b, float c, float d) { int w = __builtin_amdgcn_cvt_pk_fp8_f32(a, b, 0, false); w = __builtin_amdgcn_cvt_pk_fp8_f32(c, d, w, true); return (unsigned)w; }
__device__ __forceinline__ u32x2 pk8_fp8(const float (&f)[8]) { u32x2 r; r.x = pk4_fp8(f[0], f[1], f[2], f[3]); r.y = pk4_fp8(f[4], f[5], f[6], f[7]); return r; }
__device__ __forceinline__ f32x4 mfma8(unsigned alo, unsigned ahi, u32x2 b, f32x4 c) {
    const u32x2 a = {alo, ahi};
    return __builtin_amdgcn_mfma_f32_16x16x32_fp8_fp8(__builtin_bit_cast(long, a), __builtin_bit_cast(long, b), c, 0, 0, 0);
}
struct EpiP1 {
    static constexpr bool PERM = true, AFTER_DRAIN = false;
    bf16_t* mqkv; bf16_t* nq; bf16_t* kvrm; bf16_t* vT; float* gates;
    __device__ __forceinline__ void operator()(const f32x4 (&acc)[2][2][4][2], const pg8::Unit& u, int wr, int wc, int fr, int fq) const {
        const int pn = u.pn; const int row0 = u.pm * 256 + wr * 64 + fr;
#pragma unroll
        for (int ai = 0; ai < 2; ++ai)
#pragma unroll
            for (int m = 0; m < 4; ++m) {
                const int row = row0 + ai * 128 + m * 16; const int b = row >> 13, t = row & (T - 1);
#pragma unroll
                for (int bj = 0; bj < 2; ++bj) {
                    const f32x4 v0 = acc[ai][bj][m][0], v1 = acc[ai][bj][m][1];
                    const int c = pn * 256 + bj * 128 + wc * 32 + 8 * fq;
                    if (pn == 17) {
                        const int cc = c - 4352;
                        if (cc < 32) { float* gp = gates + (size_t)row * 32 + cc; *(f32x4*)gp = v0; *(f32x4*)(gp + 4) = v1; }
                    } else {
                        u32x4 w; w.x = pk2(v0[0], v0[1]); w.y = pk2(v0[2], v0[3]); w.z = pk2(v1[0], v1[1]); w.w = pk2(v1[2], v1[3]);
                        bf16_t* dp;
                        if (pn < 12) { const int arr = pn >> 2; dp = mqkv + (size_t)arr * ((size_t)M * 1024) + (size_t)row * 1024 + (c - arr * 1024); }
                        else if (pn < 14) { dp = nq + (size_t)row * 512 + (c - 3072); }
                        else { const int cc = c - pn * 256; const int seg = cc >> 7, g = (cc >> 6) & 1, d = cc & 63; const int arr = (pn - 14) * 2 + seg;
                               dp = kvrm + (size_t)arr * (4 * T * 64) + (size_t)((b * 2 + g) * T + t) * 64 + d; }
                        *(u32x4*)dp = w;
                    }
                }
            }
    }
};
struct EpiP2 {
    static constexpr bool PERM = true, AFTER_DRAIN = false;
    bf16_t* hn; bf16_t* yn; bf16_t* sga; bf16_t* sgb;
    __device__ __forceinline__ void operator()(const f32x4 (&acc)[2][2][4][2], const pg8::Unit& u, int wr, int wc, int fr, int fq) const {
        const int pn = u.pn; const int row0 = u.pm * 256 + wr * 64 + fr;
#pragma unroll
        for (int ai = 0; ai < 2; ++ai)
#pragma unroll
            for (int m = 0; m < 4; ++m) {
                const int row = row0 + ai * 128 + m * 16;
#pragma unroll
                for (int bj = 0; bj < 2; ++bj) {
                    const f32x4 v0 = acc[ai][bj][m][0], v1 = acc[ai][bj][m][1];
                    const int c = pn * 256 + bj * 128 + wc * 32 + 8 * fq;
                    if (pn < 8) {
                        const int ch = (c >> 3) * 4;
                        bf16_t* hp = hn + (size_t)row * 1024 + ch; const u32x2 hw = *(const u32x2*)hp;
                        const float h0 = bflo(hw.x), h1 = bfhi(hw.x), h2 = bflo(hw.y), h3 = bfhi(hw.y);
                        u32x2 o; o.x = pk2(sigmoidf_(v0[0]) * siluf_(v1[0]) * h0, sigmoidf_(v0[1]) * siluf_(v1[1]) * h1);
                        o.y = pk2(sigmoidf_(v0[2]) * siluf_(v1[2]) * h2, sigmoidf_(v0[3]) * siluf_(v1[3]) * h3);
                        *(u32x2*)hp = o;
                    } else if (pn < 10) {
                        bf16_t* yp = yn + (size_t)row * 512 + (c - 2048); const u32x4 yw = *(const u32x4*)yp; float y[8]; unpack8(yw, y);
                        u32x4 o; o.x = pk2(y[0] * siluf_(v0[0]), y[1] * siluf_(v0[1])); o.y = pk2(y[2] * siluf_(v0[2]), y[3] * siluf_(v0[3]));
                        o.z = pk2(y[4] * siluf_(v1[0]), y[5] * siluf_(v1[1])); o.w = pk2(y[6] * siluf_(v1[2]), y[7] * siluf_(v1[3]));
                        *(u32x4*)yp = o;
                    } else {
                        bf16_t* dp = (pn < 14) ? sga + (size_t)row * 1024 + (c - 2560) : sgb + (size_t)row * 1024 + (c - 3584);
                        u32x4 o; o.x = pk2(sigmoidf_(v0[0]), sigmoidf_(v0[1])); o.y = pk2(sigmoidf_(v0[2]), sigmoidf_(v0[3]));
                        o.z = pk2(sigmoidf_(v1[0]), sigmoidf_(v1[1])); o.w = pk2(sigmoidf_(v1[2]), sigmoidf_(v1[3]));
                        *(u32x4*)dp = o;
                    }
                }
            }
    }
};
struct EpiE1 {
    static constexpr bool PERM = true, AFTER_DRAIN = false;
    const bf16_t* sga; bf16_t* tmp;
    __device__ __forceinline__ void operator()(const f32x4 (&acc)[2][2][4][2], const pg8::Unit& u, int wr, int wc, int fr, int fq) const {
        const int row0 = u.pm * 256 + wr * 64 + fr;
#pragma unroll
        for (int ai = 0; ai < 2; ++ai)
#pragma unroll
            for (int m = 0; m < 4; ++m) {
                const int row = row0 + ai * 128 + m * 16;
#pragma unroll
                for (int bj = 0; bj < 2; ++bj) {
                    const f32x4 v0 = acc[ai][bj][m][0], v1 = acc[ai][bj][m][1];
                    const int c = u.pn * 256 + bj * 128 + wc * 32 + 8 * fq;
                    float s[8]; unpack8(*(const u32x4*)(sga + (size_t)row * 1024 + c), s);
                    u32x4 o; o.x = pk2(v0[0] * s[0], v0[1] * s[1]); o.y = pk2(v0[2] * s[2], v0[3] * s[3]); o.z = pk2(v1[0] * s[4], v1[1] * s[5]); o.w = pk2(v1[2] * s[6], v1[3] * s[7]);
                    *(u32x4*)(tmp + (size_t)row * 1024 + c) = o;
                }
            }
    }
};
struct EpiE2 {
    static constexpr bool PERM = true, AFTER_DRAIN = false;
    const bf16_t* sgb; const bf16_t* tmp; bf16_t* mg;
    __device__ __forceinline__ void operator()(const f32x4 (&acc)[2][2][4][2], const pg8::Unit& u, int wr, int wc, int fr, int fq) const {
        const int row0 = u.pm * 256 + wr * 64 + fr;
#pragma unroll
        for (int ai = 0; ai < 2; ++ai)
#pragma unroll
            for (int m = 0; m < 4; ++m) {
                const int row = row0 + ai * 128 + m * 16;
#pragma unroll
                for (int bj = 0; bj < 2; ++bj) {
                    const f32x4 v0 = acc[ai][bj][m][0], v1 = acc[ai][bj][m][1];
                    const int c = u.pn * 256 + bj * 128 + wc * 32 + 8 * fq;
                    float s[8]; unpack8(*(const u32x4*)(sgb + (size_t)row * 1024 + c), s);
                    float t[8]; unpack8(*(const u32x4*)(tmp + (size_t)row * 1024 + c), t);
                    u32x4 o; o.x = pk2(t[0] + v0[0] * s[0], t[1] + v0[1] * s[1]); o.y = pk2(t[2] + v0[2] * s[2], t[3] + v0[3] * s[3]);
                    o.z = pk2(t[4] + v1[0] * s[4], t[5] + v1[1] * s[5]); o.w = pk2(t[6] + v1[2] * s[6], t[7] + v1[3] * s[7]);
                    *(u32x4*)(mg + (size_t)row * 1024 + c) = o;
                }
            }
    }
};
struct EpiF {
    static constexpr bool PERM = true, AFTER_DRAIN = false;
    const float* x; float* out; float* rowss;
    __device__ __forceinline__ void operator()(const f32x4 (&acc)[2][2][4][2], const pg8::Unit& u, int wr, int wc, int fr, int fq) const {
        const int row0 = u.pm * 256 + wr * 64 + fr;
#pragma unroll
        for (int ai = 0; ai < 2; ++ai)
#pragma unroll
            for (int m = 0; m < 4; ++m) {
                const int row = row0 + ai * 128 + m * 16; float ss = 0.f;
#pragma unroll
                for (int bj = 0; bj < 2; ++bj) {
                    const int c = u.pn * 256 + bj * 128 + wc * 32 + 8 * fq;
                    const float* xp = x + (size_t)row * 1024 + c; float* op = out + (size_t)row * 1024 + c;
                    f32x4 a = *(const f32x4*)xp + acc[ai][bj][m][0], b = *(const f32x4*)(xp + 4) + acc[ai][bj][m][1];
                    *(f32x4*)op = a; *(f32x4*)(op + 4) = b;
                    ss += (a[0] * a[0] + a[1] * a[1]) + (a[2] * a[2] + a[3] * a[3]) + (b[0] * b[0] + b[1] * b[1]) + (b[2] * b[2] + b[3] * b[3]);
                }
                ss += __shfl_xor(ss, 16); ss += __shfl_xor(ss, 32);
                if (fq == 0) rowss[(size_t)row * 16 + u.pn * 4 + wc] = ss;
            }
    }
};

struct EpiFN {
    static constexpr bool PERM = true, AFTER_DRAIN = true;
    const float* x; float* out; const float* fng; float* slots; unsigned* cnt;
    __device__ __forceinline__ void fused(f32x4 (&acc)[2][2][4][2], const pg8::Unit& u, int wr, int wc, int fr, int fq, LAS unsigned char* lds, int wid, int lane) const {
        LAS float* P = (LAS float*)lds;
        LAS float* S = (LAS float*)(lds + 4096);
        const int tid = wid * 64 + lane;
#pragma unroll
        for (int ai = 0; ai < 2; ++ai)
#pragma unroll
            for (int m = 0; m < 4; ++m) {
                const int rl = ai * 128 + wr * 64 + m * 16 + fr; const int row = u.pm * 256 + rl; float ss = 0.f;
#pragma unroll
                for (int bj = 0; bj < 2; ++bj) {
                    const int c = u.pn * 256 + bj * 128 + wc * 32 + 8 * fq; const float* xp = x + (size_t)row * 1024 + c;
                    const f32x4 a = *(const f32x4*)xp + acc[ai][bj][m][0], b = *(const f32x4*)(xp + 4) + acc[ai][bj][m][1];
                    acc[ai][bj][m][0] = a; acc[ai][bj][m][1] = b;
                    ss += (a[0] * a[0] + a[1] * a[1]) + (a[2] * a[2] + a[3] * a[3]) + (b[0] * b[0] + b[1] * b[1]) + (b[2] * b[2] + b[3] * b[3]);
                }
                ss += __shfl_xor(ss, 16); ss += __shfl_xor(ss, 32);
                if (fq == 0) P[rl * 4 + wc] = ss;
            }
        __syncthreads();
        if (tid < 256) { const float t = (P[tid * 4] + P[tid * 4 + 1]) + (P[tid * 4 + 2] + P[tid * 4 + 3]);
            __hip_atomic_store(slots + (size_t)(u.pm * 256 + tid) * 4 + u.pn, t, __ATOMIC_RELAXED, __HIP_MEMORY_SCOPE_AGENT); }
        asm volatile("s_waitcnt vmcnt(0)" ::: "memory");
        __syncthreads();
        if (tid == 0) {
            __hip_atomic_fetch_add(cnt + u.pm, 1u, __ATOMIC_RELEASE, __HIP_MEMORY_SCOPE_AGENT);
            unsigned sp = 0;
            while (__hip_atomic_load(cnt + u.pm, __ATOMIC_ACQUIRE, __HIP_MEMORY_SCOPE_AGENT) < 4u) { __builtin_amdgcn_s_sleep(2); if (++sp > (1u << 22)) break; }
        }
        __syncthreads();
        if (tid < 256) { const float* sl = slots + (size_t)(u.pm * 256 + tid) * 4; float t = 0.f;
#pragma unroll
            for (int k = 0; k < 4; ++k) t += __hip_atomic_load(sl + k, __ATOMIC_RELAXED, __HIP_MEMORY_SCOPE_AGENT);
            S[tid] = 1.f / sqrtf(t * (1.f / 1024.f) + EPS); }
        __syncthreads();
#pragma unroll
        for (int ai = 0; ai < 2; ++ai)
#pragma unroll
            for (int m = 0; m < 4; ++m) {
                const int rl = ai * 128 + wr * 64 + m * 16 + fr; const int row = u.pm * 256 + rl; const float r = S[rl];
#pragma unroll
                for (int bj = 0; bj < 2; ++bj) {
                    const int c = u.pn * 256 + bj * 128 + wc * 32 + 8 * fq; float* op = out + (size_t)row * 1024 + c;
                    const f32x4 g0 = *(const f32x4*)(fng + c), g1 = *(const f32x4*)(fng + c + 4);
                    *(f32x4*)op = acc[ai][bj][m][0] * r * g0; *(f32x4*)(op + 4) = acc[ai][bj][m][1] * r * g1;
                }
            }
    }
};

__device__ __forceinline__ int win_dest(int n) {
    if (n < 3072) return n;
    if (n < 4096) { const int c = n - 3072; return 4608 + 8 * (c >> 2) + (c & 3); }
    if (n < 5120) { const int c = n - 4096; return 4608 + 8 * (c >> 2) + 4 + (c & 3); }
    if (n < 5124) return 4352 + (n - 5120);
    if (n < 5128) return 4356 + (n - 5124);
    if (n < 5640) return 3072 + (n - 5128);
    if (n < 5768) return 3584 + (n - 5640);
    if (n < 5896) return 3712 + (n - 5768);
    if (n < 6024) return 3840 + (n - 5896);
    if (n < 6152) return 4096 + (n - 6024);
    if (n < 6280) return 3968 + (n - 6152);
    if (n < 6408) return 4224 + (n - 6280);
    if (n < 6432) return 4360 + (n - 6408);
    if (n < 6944) return 4608 + 2048 + (n - 6432);
    if (n < 7968) return 4608 + 2560 + (n - 6944);
    return 4608 + 3584 + (n - 7968);
}
template <bool MAP>
__device__ __forceinline__ void transpose_item(const float* W, int K, int N, bf16_t* WT, LAS float* scr, int item, int lane) {
    const int nblk = N / 32, kb = item / nblk, nb = item % nblk, k0 = 64 * kb, n0 = 32 * nb;
#pragma unroll 8
    for (int i = 0; i < 32; ++i) { const int kk = 2 * i + (lane >> 5); scr[kk * 33 + (lane & 31)] = __builtin_nontemporal_load(W + (size_t)(k0 + kk) * N + n0 + (lane & 31)); }
    LDS_WAIT();
    const int c = lane & 7;
#pragma unroll
    for (int j = 0; j < 4; ++j) { const int n = (lane >> 3) + 8 * j; const LAS float* s = scr + (8 * c) * 33 + n;
        u32x4 o; o.x = pk2(s[0 * 33], s[1 * 33]); o.y = pk2(s[2 * 33], s[3 * 33]); o.z = pk2(s[4 * 33], s[5 * 33]); o.w = pk2(s[6 * 33], s[7 * 33]);
        const int row = MAP ? win_dest(n0 + n) : (n0 + n);
        *(u32x4*)(WT + (size_t)row * K + k0 + 8 * c) = o; }
    LDS_WAIT();
}
__device__ __forceinline__ void phaseA(const Prm& p, LAS unsigned char* L, int G) {
    const int tid = threadIdx.x, lane = tid & 63, wave = tid >> 6;
    const int gw = blockIdx.x * NWAVES + wave, NGW = G * NWAVES, gtid = blockIdx.x * NTHR + tid, NT = G * NTHR;
    unsigned char* ws = p.ws;
    LAS float* scr = (LAS float*)(L + wave * 16384);
    constexpr int NB_E = 137, I_WIN = 16 * NB_E, I_W1 = 32 * 4, I_W2 = 2 * 2;
    constexpr int NITEMS = I_WIN + 2 * I_W1 + 2 * I_W2;
    for (int it = gw; it < NITEMS; it += NGW) {
        int r = it;
        if (r < I_WIN) { const int kb = r / NB_E, ib = r % NB_E, nb = ib < 96 ? ib : ib + 64; transpose_item<true>(p.w_in, 1024, INW, (bf16_t*)(ws + WS_WIN), scr, kb * 281 + nb, lane); continue; } r -= I_WIN;
        if (r < I_W1) { transpose_item<false>(p.cw1k, 2048, 128, (bf16_t*)(ws + WS_W1KT), scr, r, lane); continue; } r -= I_W1;
        if (r < I_W1) { transpose_item<false>(p.cw1v, 2048, 128, (bf16_t*)(ws + WS_W1VT), scr, r, lane); continue; } r -= I_W1;
        if (r < I_W2) { transpose_item<false>(p.cw2k, 128, 64, (bf16_t*)(ws + WS_W2KT), scr, r, lane); continue; } r -= I_W2;
        transpose_item<false>(p.cw2v, 128, 64, (bf16_t*)(ws + WS_W2VT), scr, r, lane);
    }
    {
        u32x4* z = (u32x4*)(ws + WS_WIN + (size_t)4384 * 2048);
        for (int i = gtid; i < 224 * 128; i += NT) z[i] = (u32x4){0u, 0u, 0u, 0u};
    }
    bf16_t* XN = (bf16_t*)(ws + WS_XN);
    for (int m0 = gw; m0 < M; m0 += 4 * NGW) {
        f32x4 v[4][4]; float ss[4];
#pragma unroll
        for (int q = 0; q < 4; ++q) { const int m = m0 + q * NGW < M ? m0 + q * NGW : m0; const f32x4* xr = (const f32x4*)(p.x + (size_t)m * D) + lane;
#pragma unroll
            for (int j = 0; j < 4; ++j) v[q][j] = __builtin_nontemporal_load(xr + 64 * j); }
#pragma unroll
        for (int q = 0; q < 4; ++q) { float s_ = 0.f;
#pragma unroll
            for (int j = 0; j < 4; ++j) s_ += (v[q][j][0] * v[q][j][0] + v[q][j][1] * v[q][j][1]) + (v[q][j][2] * v[q][j][2] + v[q][j][3] * v[q][j][3]);
            ss[q] = s_; }
#pragma unroll
        for (int q = 0; q < 4; ++q) ss[q] = wave_sum(ss[q]);
#pragma unroll
        for (int q = 0; q < 4; ++q) { const int m = m0 + q * NGW; if (m < M) {
            const float r = 1.f / sqrtf(ss[q] * (1.f / D) + EPS); const f32x4* gr = (const f32x4*)p.norm_g + lane;
            u32x2* o8 = (u32x2*)(XN + (size_t)m * D) + lane;
#pragma unroll
            for (int j = 0; j < 4; ++j) { const f32x4 g = gr[64 * j]; u32x2 o; o.x = pk2(v[q][j][0] * r * g[0], v[q][j][1] * r * g[1]); o.y = pk2(v[q][j][2] * r * g[2], v[q][j][3] * r * g[3]); o8[64 * j] = o; } } }
    }
    if (blockIdx.x == 0 && tid < 64) ((unsigned*)(ws + OFF_CTR))[tid] = 0u;
    {
        float* tab = (float*)(ws + OFF_ROPE);
        for (int i = gtid; i < M * 8; i += NT) { const int bt = i >> 3, k = i & 7; const float inv = powf(500000.0f, -(float)k * 0.125f);
            const float ang = (float)p.pos[bt] * inv; tab[bt * 16 + k] = cosf(ang); tab[bt * 16 + 8 + k] = sinf(ang); }
    }
}

__device__ __forceinline__ void deferred_weights(const Prm& p, LAS unsigned char* L, int G) {
    const int tid = threadIdx.x, lane = tid & 63, wave = tid >> 6;
    const int half = G / 2; if ((int)blockIdx.x < half) return;
    const int gw = ((int)blockIdx.x - half) * NWAVES + wave, NGW = (G - half) * NWAVES;
    unsigned char* ws = p.ws;
    LAS float* scr = (LAS float*)(L + wave * 16384);
    constexpr int NB_D = 144, I_WIN = 16 * NB_D, I_A = 16 * 32, I_B = 8 * 32, I_O = 16 * 32;
    constexpr int NITEMS = I_WIN + I_A + I_B + I_O;
    for (int it = gw; it < NITEMS; it += NGW) {
        int r = it;
        if (r < I_WIN) { const int kb = r / NB_D, ib = r % NB_D, nb = ib < 64 ? 96 + ib : 201 + (ib - 64); transpose_item<true>(p.w_in, 1024, INW, (bf16_t*)(ws + WS_WIN), scr, kb * 281 + nb, lane); continue; } r -= I_WIN;
        if (r < I_A) { transpose_item<false>(p.wa, 1024, 1024, (bf16_t*)(ws + WS_WA), scr, r, lane); continue; } r -= I_A;
        if (r < I_B) { transpose_item<false>(p.wb, 512, 1024, (bf16_t*)(ws + WS_WB), scr, r, lane); continue; } r -= I_B;
        transpose_item<false>(p.wo, 1024, 1024, (bf16_t*)(ws + WS_WO), scr, r, lane);
    }
}

__device__ __forceinline__ void phaseC1(const Prm& p, LAS unsigned char* L, int G) {
    const int tid = threadIdx.x, lane = tid & 63, wave = tid >> 6, fr = lane & 15, fq = lane >> 4;
    const int gw = blockIdx.x * NWAVES + wave, gtid = blockIdx.x * NTHR + tid, NT = G * NTHR;
    unsigned char* ws = p.ws;
    const float* gates = (const float*)(ws + WS_GATES);
    if (blockIdx.x < 8) {
        const int bh = blockIdx.x, b = bh >> 2, h = bh & 3;
        float* lcf = (float*)(ws + OFF_LCF) + bh * T; float* mtv = (float*)(ws + OFF_MT) + bh * T; float* liv = (float*)(ws + OFF_LI) + bh * T;
        LAS float* red = (LAS float*)L;
        const float bfv = p.bfg[h], biv = p.big[h];
        float cf[16], li[16]; float run = 0.f;
#pragma unroll
        for (int k = 0; k < 16; ++k) { const float* gp = gates + (size_t)(b * T + tid * 16 + k) * 32; const float fp = gp[4 + h] + bfv; li[k] = gp[h] + biv;
            run += fminf(fp, 0.f) - log1pf(expf(-fabsf(fp))); cf[k] = run; }
        float inc = run;
#pragma unroll
        for (int o = 1; o < 64; o <<= 1) { const float v = __shfl_up(inc, o); if (lane >= o) inc += v; }
        if (lane == 63) red[wave] = inc;
        __syncthreads();
        float base = inc - run;
        for (int w = 0; w < wave; ++w) base += red[w];
        float pm[16]; float tm = -INFINITY;
#pragma unroll
        for (int k = 0; k < 16; ++k) { cf[k] += base; tm = fmaxf(tm, li[k] - cf[k]); pm[k] = tm; }
        float incm = tm;
#pragma unroll
        for (int o = 1; o < 64; o <<= 1) { const float v = __shfl_up(incm, o); if (lane >= o) incm = fmaxf(incm, v); }
        if (lane == 63) red[8 + wave] = incm;
        float exm = __shfl_up(incm, 1); if (lane == 0) exm = -INFINITY;
        __syncthreads();
        float R0 = fmaxf(0.f, exm);
        for (int w = 0; w < wave; ++w) R0 = fmaxf(R0, red[8 + w]);
#pragma unroll
        for (int k = 0; k < 16; ++k) { const int t = tid * 16 + k; const float R = fmaxf(R0, pm[k]); lcf[t] = cf[k]; mtv[t] = cf[k] + R; liv[t] = li[k]; }
        __syncthreads();
    }
    {
        LAS bf16_t* H = (LAS bf16_t*)L;
        for (int u = blockIdx.x; u < 256; u += G) {
            const int which = u >> 7, bg = (u >> 5) & 3, it = u & 31;
            const bf16_t* src = (const bf16_t*)(ws + WS_KVRM) + (size_t)which * (4 * T * 64) + (size_t)bg * T * 64;
            const float* pos = which ? p.cpv : p.cpk;
            const bf16_t* w1T = (const bf16_t*)(ws + (which ? WS_W1VT : WS_W1KT)); const bf16_t* w2T = (const bf16_t*)(ws + (which ? WS_W2VT : WS_W2KT));
            const int irow = it * 16 + fr, ic = irow < 511 ? irow : 510;
            const bf16_t* ab = src + (size_t)ic * 1024 + wave * 256; const float* pw = pos + wave * 256; const bf16_t* bb = w1T + (size_t)fr * 2048 + wave * 256;
            f32x4 acc[8];
#pragma unroll
            for (int nt = 0; nt < 8; ++nt) acc[nt] = (f32x4){0.f, 0.f, 0.f, 0.f};
#pragma unroll 2
            for (int ks = 0; ks < 8; ++ks) {
                const int k = ks * 32 + fq * 8;
                float a[8]; unpack8(*(const u32x4*)(ab + k), a);
                const f32x4 p0 = *(const f32x4*)(pw + k), p1 = *(const f32x4*)(pw + k + 4);
                a[0] += p0[0]; a[1] += p0[1]; a[2] += p0[2]; a[3] += p0[3]; a[4] += p1[0]; a[5] += p1[1]; a[6] += p1[2]; a[7] += p1[3];
                const bf16x8 af = __builtin_bit_cast(bf16x8, pack8(a));
#pragma unroll
                for (int nt = 0; nt < 8; ++nt) acc[nt] = mfma16(af, *(const bf16x8*)(bb + (size_t)nt * 16 * 2048 + k), acc[nt]);
            }
            LAS float* Pp = (LAS float*)(L + 8192);
#pragma unroll
            for (int nt = 0; nt < 8; ++nt)
#pragma unroll
                for (int j = 0; j < 4; ++j) Pp[wave * 2048 + (fq * 4 + j) * 128 + nt * 16 + fr] = acc[nt][j];
            __syncthreads();
            {   const int idx = tid * 4; f32x4 sum = *(const LAS f32x4*)(Pp + idx);
#pragma unroll
                for (int w = 1; w < 8; ++w) sum += *(const LAS f32x4*)(Pp + w * 2048 + idx);
                const int i = idx >> 7, n = idx & 127;
#pragma unroll
                for (int j = 0; j < 4; ++j) { const float v = sum[j]; const float gl = 0.5f * v * (1.f + tanhf(0.7978845608028654f * (v + 0.044715f * v * v * v)));
                    H[i * 136 + n + j] = (bf16_t)f2bf(gl); } }
            __syncthreads();
            if (wave < 4) {
                f32x4 a2 = {0.f, 0.f, 0.f, 0.f};
#pragma unroll
                for (int ks = 0; ks < 4; ++ks)
                    a2 = mfma16(*(const LAS bf16x8*)(H + fr * 136 + ks * 32 + fq * 8), *(const bf16x8*)(w2T + (size_t)(wave * 16 + fr) * 128 + ks * 32 + fq * 8), a2);
                const int i0 = it * 16 + fq * 4, d = wave * 16 + fr;
                const int tile = it >> 2, kt = it & 3;
                if (which == 0) { bf16_t* kc = (bf16_t*)(ws + WS_KC) + (size_t)bg * 512 * 64 + tile * 4096;
#pragma unroll
                    for (int j = 0; j < 4; ++j) kc[((kt * 2 + (d >> 5)) * 64 + ((d >> 3) & 3) * 16 + fq * 4 + j) * 8 + (d & 7)] = (i0 + j < 511) ? (bf16_t)f2bf(a2[j]) : (bf16_t)0;
                } else { bf16_t* vc = (bf16_t*)(ws + WS_VCT) + (size_t)bg * 512 * 64 + tile * 4096;
                    u32x2 o; o.x = pk2(a2[0], a2[1]); o.y = pk2(a2[2], (i0 + 3 < 511) ? a2[3] : 0.f);
                    *(u32x2*)(vc + (((kt >> 1) * 4 + wave) * 64 + fq * 16 + fr) * 8 + (kt & 1) * 4) = o; }
            }
            __syncthreads();
        }
    }
    {
        const float* tab = (const float*)(ws + OFF_ROPE);
        LAS bf16_t* tl = (LAS bf16_t*)(L + wave * 16384);
        const int NGW = G * NWAVES;
        for (int item = gw; item < 4 * 4 * 128; item += NGW) {
            const int tile = item & 127, bg = (item >> 7) & 3, arr = 2 + (item >> 9);
            bf16_t* tp = (bf16_t*)(ws + WS_KVRM) + (size_t)arr * (4 * T * 64) + (size_t)(bg * T + tile * 64) * 64;
            if (arr < 4) {
                u32x4 f[8];
#pragma unroll
                for (int kt = 0; kt < 4; ++kt)
#pragma unroll
                    for (int ks = 0; ks < 2; ++ks) f[kt * 2 + ks] = *(const u32x4*)(tp + (kt * 16 + fr) * 64 + ks * 32 + fq * 8);
#pragma unroll
                for (int kt = 0; kt < 4; ++kt) {
                    u32x4 q0 = f[kt * 2];
                    u32x4 ot; ot.x = __shfl_xor(q0.x, 16); ot.y = __shfl_xor(q0.y, 16); ot.z = __shfl_xor(q0.z, 16); ot.w = __shfl_xor(q0.w, 16);
                    if (fq < 2) {
                        const float* tb = tab + (size_t)((bg >> 1) * T + tile * 64 + kt * 16 + fr) * 16; float mine[8], oth[8], r[8]; unpack8(q0, mine); unpack8(ot, oth);
                        const float sg = fq == 0 ? -1.f : 1.f;
#pragma unroll
                        for (int e = 0; e < 8; ++e) r[e] = mine[e] * tb[e] + sg * oth[e] * tb[8 + e];
                        f[kt * 2] = pack8(r);
                    }
                }
                asm volatile("s_waitcnt vmcnt(0)" ::: "memory");
#pragma unroll
                for (int kt = 0; kt < 4; ++kt) { float a0[8], a1[8]; unpack8(f[kt * 2], a0); unpack8(f[kt * 2 + 1], a1); const u32x2 lo = pk8_fp8(a0), hi = pk8_fp8(a1);
                    u32x4 o; o.x = lo.x; o.y = lo.y; o.z = hi.x; o.w = hi.y; *(u32x4*)((char*)tp + (kt * 64 + lane) * 16) = o; }
            } else {
#pragma unroll
                for (int i = 0; i < 8; ++i) { const int idx = i * 64 + lane, r = idx >> 3, ch = idx & 7; *(LAS u32x4*)(tl + r * 72 + ch * 8) = *(const u32x4*)(tp + r * 64 + ch * 8); }
                asm volatile("s_waitcnt vmcnt(0) lgkmcnt(0)" ::: "memory");
#pragma unroll
                for (int hf = 0; hf < 2; ++hf)
#pragma unroll
                    for (int dp = 0; dp < 2; ++dp) {
                        u32x2 h2[2];
#pragma unroll
                        for (int d2 = 0; d2 < 2; ++d2) { const int dt = dp * 2 + d2; float fv[8];
#pragma unroll
                            for (int j = 0; j < 4; ++j) { fv[j] = bflo((unsigned)tl[(hf * 32 + fq * 4 + j) * 72 + dt * 16 + fr]); fv[4 + j] = bflo((unsigned)tl[(hf * 32 + 16 + fq * 4 + j) * 72 + dt * 16 + fr]); }
                            h2[d2] = pk8_fp8(fv); }
                        u32x4 o; o.x = h2[0].x; o.y = h2[0].y; o.z = h2[1].x; o.w = h2[1].y;
                        *(u32x4*)((char*)tp + ((hf * 2 + dp) * 64 + lane) * 16) = o;
                    }
                asm volatile("s_waitcnt lgkmcnt(0)" ::: "memory");
            }
        }
    }
}

__device__ __forceinline__ void phaseC2(const Prm& p, LAS unsigned char* L, int G) {
    const int tid = threadIdx.x, lane = tid & 63, wave = tid >> 6, fr = lane & 15, fq = lane >> 4;
    unsigned char* ws = p.ws;
    LAS bf16_t* Qs = (LAS bf16_t*)L;
    LAS bf16_t* Ks = (LAS bf16_t*)(L + 33792);
    LAS bf16_t* Ss = (LAS bf16_t*)(L + 67584);
    LAS float* sc = (LAS float*)(L + 76800);
    const bf16_t* MQr = (const bf16_t*)(ws + WS_MQ); const bf16_t* MKr = (const bf16_t*)(ws + WS_MK);
    bf16_t* Qt = (bf16_t*)p.out; bf16_t* KT = Qt + (size_t)M * 1024; bf16_t* SP = (bf16_t*)(ws + WS_SP);
    for (int u = blockIdx.x; u < 1024; u += G) {
        const int bh = u >> 7, c = u & 127, b = bh >> 2, h = bh & 3; const size_t row0 = (size_t)b * T + c * 64; const int s0i = bh * T + c * 64;
        const float* lcf = (const float*)(ws + OFF_LCF); const float* mtv = (const float*)(ws + OFF_MT); const float* liv = (const float*)(ws + OFF_LI);
#pragma unroll
        for (int which = 0; which < 2; ++which) {
            const bf16_t* src = (which ? MKr : MQr) + h * 256 + (tid & 31) * 8; const float* cw = (which ? p.ckw : p.cqw) + h * 256 + (tid & 31) * 8; const float* cb = (which ? p.ckb : p.cqb) + h * 256 + (tid & 31) * 8;
            const float osc = which ? 0.0625f : 1.0f; LAS bf16_t* dstl = which ? Ks : Qs;
            float w0[8], w1[8], w2[8], w3[8], bs[8];
#pragma unroll
            for (int e = 0; e < 8; ++e) { w0[e] = cw[e]; w1[e] = cw[1024 + e]; w2[e] = cw[2048 + e]; w3[e] = cw[3072 + e]; bs[e] = cb[e]; }
#pragma unroll
            for (int i = 0; i < 4; ++i) { const int r = (tid + i * 512) >> 5; const int tt = c * 64 + r;
                u32x4 x0 = {0u, 0u, 0u, 0u}, x1 = x0, x2 = x0; const bf16_t* rp = src + (row0 + r) * 1024;
                if (tt >= 3) x0 = *(const u32x4*)(rp - 3 * 1024);
                if (tt >= 2) x1 = *(const u32x4*)(rp - 2 * 1024);
                if (tt >= 1) x2 = *(const u32x4*)(rp - 1 * 1024);
                const u32x4 x3 = *(const u32x4*)rp;
                float a0[8], a1[8], a2[8], a3[8], o[8]; unpack8(x0, a0); unpack8(x1, a1); unpack8(x2, a2); unpack8(x3, a3);
#pragma unroll
                for (int e = 0; e < 8; ++e) { const float v = bs[e] + w0[e] * a0[e] + w1[e] * a1[e] + w2[e] * a2[e] + w3[e] * a3[e]; o[e] = siluf_(v) * osc; }
                *(LAS u32x4*)(dstl + r * 264 + (tid & 31) * 8) = pack8(o); }
        }
        if (tid < 64) { const float lc = lcf[s0i + tid], mt_ = mtv[s0i + tid], li_ = liv[s0i + tid]; const float lce = lcf[s0i + 63], mte = mtv[s0i + 63];
            sc[tid] = lc; sc[64 + tid] = mt_; sc[128 + tid] = li_; sc[192 + tid] = 0.f; sc[256 + tid] = __expf(lce - lc + li_ - mte);
            if (tid == 0) { const float pF = c ? lcf[s0i - 1] : 0.f, pM = c ? mtv[s0i - 1] : 0.f; sc[320] = pM - pF; sc[321] = mte - lce; } }
        __syncthreads();
        const float Rprev = sc[320];
        {
            const int lt = wave >> 1, st0 = (wave & 1) * 2;
            f32x4 acc[2] = {{0.f, 0.f, 0.f, 0.f}, {0.f, 0.f, 0.f, 0.f}};
#pragma unroll
            for (int ks = 0; ks < 8; ++ks) {
                const bf16x8 a = *(const LAS bf16x8*)(Qs + (lt * 16 + fr) * 264 + ks * 32 + fq * 8);
                const bf16x8 b0 = *(const LAS bf16x8*)(Ks + (st0 * 16 + fr) * 264 + ks * 32 + fq * 8);
                const bf16x8 b1 = *(const LAS bf16x8*)(Ks + ((st0 + 1) * 16 + fr) * 264 + ks * 32 + fq * 8);
                acc[0] = mfma16(a, b0, acc[0]); acc[1] = mfma16(a, b1, acc[1]);
            }
            float rp[4] = {0.f, 0.f, 0.f, 0.f};
#pragma unroll
            for (int i = 0; i < 2; ++i) { const int s = (st0 + i) * 16 + fr; const float cs = sc[128 + s] - sc[s];
#pragma unroll
                for (int j = 0; j < 4; ++j) { const int l = lt * 16 + fq * 4 + j;
                    const float v = (s <= l) ? acc[i][j] * __expf(sc[l] + cs - sc[64 + l]) : 0.f;
                    const unsigned bfv = f2bf(v); Ss[l * 72 + s] = (bf16_t)bfv; rp[j] += bflo(bfv); } }
#pragma unroll
            for (int j = 0; j < 4; ++j) { float v = rp[j]; v += __shfl_xor(v, 1); v += __shfl_xor(v, 2); v += __shfl_xor(v, 4); v += __shfl_xor(v, 8);
                if (fr == 0) atomicAdd((float*)(sc + 192 + lt * 16 + fq * 4 + j), v); }
        }
        __syncthreads();
        {
            { const int r = tid >> 3, ch = tid & 7; *(u32x4*)(SP + (size_t)u * 4096 + r * 64 + ch * 8) = *(const LAS u32x4*)(Ss + r * 72 + ch * 8); }
            if (tid < 64) ((float*)(ws + OFF_RS))[s0i + tid] = sc[192 + tid];
            if (tid == 0) ((float*)(ws + OFF_DEC))[u] = __expf(Rprev - sc[321]);
#pragma unroll
            for (int i = 0; i < 4; ++i) { const int idx = tid + i * 512, r = idx >> 5, ch = idx & 31;
                const float w = __expf(Rprev - (sc[64 + r] - sc[r]));
                float q[8]; unpack8(*(const LAS u32x4*)(Qs + r * 264 + ch * 8), q);
#pragma unroll
                for (int e = 0; e < 8; ++e) q[e] *= w;
                *(u32x4*)(Qt + (row0 + r) * 1024 + h * 256 + ch * 8) = pack8(q); }
            float* kn = (float*)(ws + WS_KN) + (size_t)u * 256;
#pragma unroll
            for (int i = 0; i < 4; ++i) { const int idx = tid + i * 512, d = idx >> 3, scn = idx & 7, s0 = scn * 8;
                float kv[8]; float sum = 0.f; unsigned hb[8];
#pragma unroll
                for (int j = 0; j < 8; ++j) { const float v = bflo((unsigned)Ks[(s0 + j) * 264 + d]) * sc[256 + s0 + j]; hb[j] = f2bf(v); kv[j] = bflo(hb[j]); sum += kv[j]; }
                u32x4 o; o.x = hb[0] | (hb[1] << 16); o.y = hb[2] | (hb[3] << 16); o.z = hb[4] | (hb[5] << 16); o.w = hb[6] | (hb[7] << 16);
                *(u32x4*)(KT + (size_t)u * 16384 + d * 64 + s0) = o;
                sum += __shfl_xor(sum, 1); sum += __shfl_xor(sum, 2); sum += __shfl_xor(sum, 4);
                if (scn == 0) kn[d] = sum; }
        }
        __syncthreads();
    }
}

__device__ __forceinline__ void mlstm_scan(const Prm& p, LAS unsigned char* L) {
    const int tid = threadIdx.x, lane = tid & 63, wave = tid >> 6, fr = lane & 15, fq = lane >> 4;
    unsigned char* ws = p.ws;
    const int mb = blockIdx.x >> 2, bh = mb >> 3, es = mb & 7, b = bh >> 2, h = bh & 3;
    LAS bf16_t* Qs = (LAS bf16_t*)L;
    LAS bf16_t* Ss = (LAS bf16_t*)(L + 33792);
    LAS bf16_t* VTs = (LAS bf16_t*)(L + 43008);
    LAS bf16_t* CTs = (LAS bf16_t*)(L + 47616);
    LAS float* dcs = (LAS float*)(L + 64512);
    const bf16_t* Qt = (const bf16_t*)p.out; const bf16_t* KT = Qt + (size_t)M * 1024; const bf16_t* SP = (const bf16_t*)(ws + WS_SP);
    const bf16_t* MV = (const bf16_t*)(ws + WS_MV); bf16_t* NUM = (bf16_t*)(ws + WS_NUM); const float* dec = (const float*)(ws + OFF_DEC);
    for (int i = tid; i < 32 * 264 / 2; i += NTHR) ((LAS unsigned*)CTs)[i] = 0u;
    if (tid < 128) dcs[tid] = dec[bh * 128 + tid];
    f32x4 acc[2][2];
#pragma unroll
    for (int i = 0; i < 2; ++i)
#pragma unroll
        for (int e = 0; e < 2; ++e) acc[i][e] = (f32x4){0.f, 0.f, 0.f, 0.f};
    u32x4 rqA[4], rsA, rvA, rqB[4], rsB, rvB; bf16x8 kA[4], kB[4], kc[4];
    const int qr[4] = {tid >> 5, (tid + 512) >> 5, (tid + 1024) >> 5, (tid + 1536) >> 5}; const int qch = tid & 31;
    const int sr = tid >> 3, sch = tid & 7;
    const int vr = (tid & 255) >> 2, vch = tid & 3;
#define MS_LOAD(c, X) do { const size_t row0 = (size_t)b * T + (size_t)(c) * 64; const size_t u = (size_t)bh * 128 + (c); \
        _Pragma("unroll") for (int i = 0; i < 4; ++i) rq##X[i] = *(const u32x4*)(Qt + (row0 + qr[i]) * 1024 + h * 256 + qch * 8); \
        _Pragma("unroll") for (int i = 0; i < 2; ++i) _Pragma("unroll") for (int ks = 0; ks < 2; ++ks) k##X[i * 2 + ks] = *(const bf16x8*)(KT + u * 16384 + (size_t)((2 * wave + i) * 16 + fr) * 64 + ks * 32 + fq * 8); \
        rs##X = *(const u32x4*)(SP + u * 4096 + tid * 8); if (tid < 256) rv##X = *(const u32x4*)(MV + (row0 + vr) * 1024 + h * 256 + es * 32 + vch * 8); } while (0)
#define MS_STORE(X) do { \
        _Pragma("unroll") for (int i = 0; i < 4; ++i) { *(LAS u32x4*)(Qs + qr[i] * 264 + qch * 8) = rq##X[i]; kc[i] = k##X[i]; } \
        *(LAS u32x4*)(Ss + sr * 72 + sch * 8) = rs##X; \
        if (tid < 256) { \
        VTs[(vch * 8 + 0) * 72 + vr] = (bf16_t)(rv##X.x & 0xffffu); VTs[(vch * 8 + 1) * 72 + vr] = (bf16_t)(rv##X.x >> 16); VTs[(vch * 8 + 2) * 72 + vr] = (bf16_t)(rv##X.y & 0xffffu); VTs[(vch * 8 + 3) * 72 + vr] = (bf16_t)(rv##X.y >> 16); \
        VTs[(vch * 8 + 4) * 72 + vr] = (bf16_t)(rv##X.z & 0xffffu); VTs[(vch * 8 + 5) * 72 + vr] = (bf16_t)(rv##X.z >> 16); VTs[(vch * 8 + 6) * 72 + vr] = (bf16_t)(rv##X.w & 0xffffu); VTs[(vch * 8 + 7) * 72 + vr] = (bf16_t)(rv##X.w >> 16); } } while (0)
    const int lt = wave >> 1, et = wave & 1;
#define MS_BODY(c, LDSET, STSET) do { \
        const float dc = dcs[(c)]; \
        if ((c) + 2 < 128) MS_LOAD((c) + 2, LDSET); \
        f32x4 na = {0.f, 0.f, 0.f, 0.f}; \
        _Pragma("unroll") for (int ks = 0; ks < 8; ++ks) na = mfma16(*(const LAS bf16x8*)(Qs + (lt * 16 + fr) * 264 + ks * 32 + fq * 8), *(const LAS bf16x8*)(CTs + (et * 16 + fr) * 264 + ks * 32 + fq * 8), na); \
        _Pragma("unroll") for (int ks = 0; ks < 2; ++ks) na = mfma16(*(const LAS bf16x8*)(Ss + (lt * 16 + fr) * 72 + ks * 32 + fq * 8), *(const LAS bf16x8*)(VTs + (et * 16 + fr) * 72 + ks * 32 + fq * 8), na); \
        {   const size_t row0 = (size_t)b * T + (size_t)(c) * 64; \
            _Pragma("unroll") for (int j = 0; j < 4; ++j) NUM[(row0 + lt * 16 + fq * 4 + j) * 1024 + h * 256 + es * 32 + et * 16 + fr] = (bf16_t)f2bf(na[j]); } \
        _Pragma("unroll") for (int i = 0; i < 2; ++i) _Pragma("unroll") for (int e = 0; e < 2; ++e) acc[i][e] *= dc; \
        _Pragma("unroll") for (int ks = 0; ks < 2; ++ks) _Pragma("unroll") for (int e = 0; e < 2; ++e) { const bf16x8 bv = *(const LAS bf16x8*)(VTs + (e * 16 + fr) * 72 + ks * 32 + fq * 8); \
                acc[0][e] = mfma16(kc[ks], bv, acc[0][e]); acc[1][e] = mfma16(kc[2 + ks], bv, acc[1][e]); } \
        __syncthreads(); \
        _Pragma("unroll") for (int i = 0; i < 2; ++i) _Pragma("unroll") for (int e = 0; e < 2; ++e) { u32x2 o; o.x = pk2(acc[i][e][0], acc[i][e][1]); o.y = pk2(acc[i][e][2], acc[i][e][3]); \
                *(LAS u32x2*)(CTs + (e * 16 + fr) * 264 + (2 * wave + i) * 16 + fq * 4) = o; } \
        if ((c) + 1 < 128) MS_STORE(STSET); \
        __syncthreads(); } while (0)
    MS_LOAD(0, A); MS_STORE(A);
    MS_LOAD(1, B);
    __syncthreads();
    for (int c = 0; c < 128; c += 2) {
        MS_BODY(c, A, B);
        MS_BODY(c + 1, B, A);
    }
#undef MS_BODY
#undef MS_LOAD
#undef MS_STORE
}

__device__ __forceinline__ void st_tile(const bf16_t* Kp, const bf16x8 (&qf)[2], int fr, int fq, f32x4 (&st)[4]) {
#pragma unroll
    for (int kt = 0; kt < 4; ++kt) {
        f32x4 a = {0.f, 0.f, 0.f, 0.f};
#pragma unroll
        for (int ks = 0; ks < 2; ++ks) a = mfma16(*(const bf16x8*)(Kp + (size_t)(kt * 16 + fr) * 64 + ks * 32 + fq * 8), qf[ks], a);
        st[kt] = a;
    }
}
__device__ __forceinline__ void pv_tile(const bf16_t* VTp, int vp, const f32x4 (&pr)[4], int fr, int fq, f32x4 (&o)[4]) {
#pragma unroll
    for (int i = 0; i < 2; ++i) {
        u32x4 pw; pw.x = pk2(pr[2 * i][0], pr[2 * i][1]); pw.y = pk2(pr[2 * i][2], pr[2 * i][3]); pw.z = pk2(pr[2 * i + 1][0], pr[2 * i + 1][1]); pw.w = pk2(pr[2 * i + 1][2], pr[2 * i + 1][3]);
        const bf16x8 pb = __builtin_bit_cast(bf16x8, pw);
#pragma unroll
        for (int dt = 0; dt < 4; ++dt) {
            const bf16_t* r = VTp + (size_t)(dt * 16 + fr) * vp + i * 32 + fq * 4;
            const u32x2 lo = *(const u32x2*)r, hi = *(const u32x2*)(r + 16);
            u32x4 vw; vw.x = lo.x; vw.y = lo.y; vw.z = hi.x; vw.w = hi.y;
            o[dt] = mfma16(__builtin_bit_cast(bf16x8, vw), pb, o[dt]);
        }
    }
}
__device__ __forceinline__ void st_tile_frag(const bf16_t* Kt, const bf16x8 (&qf)[2], int lane, f32x4 (&st)[4]) {
#pragma unroll
    for (int kt = 0; kt < 4; ++kt) { f32x4 a = {0.f, 0.f, 0.f, 0.f};
        a = mfma16(*(const bf16x8*)(Kt + ((kt * 2) * 64 + lane) * 8), qf[0], a); a = mfma16(*(const bf16x8*)(Kt + ((kt * 2 + 1) * 64 + lane) * 8), qf[1], a); st[kt] = a; }
}
__device__ __forceinline__ void pv_tile_frag(const bf16_t* Vt, const f32x4 (&pr)[4], int lane, f32x4 (&o)[4]) {
#pragma unroll
    for (int i = 0; i < 2; ++i) {
        u32x4 pw; pw.x = pk2(pr[2 * i][0], pr[2 * i][1]); pw.y = pk2(pr[2 * i][2], pr[2 * i][3]); pw.z = pk2(pr[2 * i + 1][0], pr[2 * i + 1][1]); pw.w = pk2(pr[2 * i + 1][2], pr[2 * i + 1][3]);
        const bf16x8 pb = __builtin_bit_cast(bf16x8, pw);
#pragma unroll
        for (int dt = 0; dt < 4; ++dt) o[dt] = mfma16(*(const bf16x8*)(Vt + ((i * 4 + dt) * 64 + lane) * 8), pb, o[dt]);
    }
}
template <bool FULL>
__device__ __forceinline__ void cmp_p1_tile(f32x4 (&st)[4], int tile, int fq, int nc_col, float& m2, float& l) {
    constexpr float C = 0.125f * 1.4426950408889634f;
    float mx = -1e30f;
#pragma unroll
    for (int kt = 0; kt < 4; ++kt)
#pragma unroll
        for (int j = 0; j < 4; ++j) if (FULL || (tile * 64 + kt * 16 + fq * 4 + j < nc_col)) mx = fmaxf(mx, st[kt][j]);
    mx = fmaxf(mx, __shfl_xor(mx, 16)); mx = fmaxf(mx, __shfl_xor(mx, 32));
    const float mn2 = fmaxf(m2, mx * C); float ps = 0.f;
#pragma unroll
    for (int kt = 0; kt < 4; ++kt)
#pragma unroll
        for (int j = 0; j < 4; ++j) if (FULL || (tile * 64 + kt * 16 + fq * 4 + j < nc_col)) ps += __builtin_amdgcn_exp2f(__builtin_fmaf(st[kt][j], C, -mn2));
    l = l * __builtin_amdgcn_exp2f(m2 - mn2) + ps; m2 = mn2;
}
template <bool FULL>
__device__ __forceinline__ void cmp_p2_tile(f32x4 (&st)[4], int tile, int fq, int nc_col, float off2) {
    constexpr float C = 0.125f * 1.4426950408889634f;
#pragma unroll
    for (int kt = 0; kt < 4; ++kt)
#pragma unroll
        for (int j = 0; j < 4; ++j) st[kt][j] = (FULL || (tile * 64 + kt * 16 + fq * 4 + j < nc_col)) ? __builtin_amdgcn_exp2f(__builtin_fmaf(st[kt][j], C, off2)) : 0.f;
}
__device__ __forceinline__ void online_step(f32x4 (&st)[4], unsigned vmask, float& m, float& l, f32x4 (&o)[4]) {
    float mx = -1e30f;
#pragma unroll
    for (int kt = 0; kt < 4; ++kt)
#pragma unroll
        for (int j = 0; j < 4; ++j) if ((vmask >> (kt * 4 + j)) & 1u) mx = fmaxf(mx, st[kt][j]);
    mx = fmaxf(mx, __shfl_xor(mx, 16)); mx = fmaxf(mx, __shfl_xor(mx, 32));
    const float mn = fmaxf(m, mx); const float alpha = __expf(m - mn);
    float ps = 0.f;
#pragma unroll
    for (int kt = 0; kt < 4; ++kt)
#pragma unroll
        for (int j = 0; j < 4; ++j) { const float pv = ((vmask >> (kt * 4 + j)) & 1u) ? __expf(st[kt][j] - mn) : 0.f; st[kt][j] = pv; ps += pv; }
    ps += __shfl_xor(ps, 16); ps += __shfl_xor(ps, 32);
    l = l * alpha + ps; m = mn;
#pragma unroll
    for (int dt = 0; dt < 4; ++dt) o[dt] *= alpha;
}
__device__ __forceinline__ void load_tile8(const bf16_t* Kt, const bf16_t* Vt, int lane, u32x4 (&k)[4], u32x4 (&v)[4]) {
#pragma unroll
    for (int i = 0; i < 4; ++i) { k[i] = *(const u32x4*)((const char*)Kt + (i * 64 + lane) * 16);
                                  v[i] = *(const u32x4*)((const char*)Vt + (i * 64 + lane) * 16); }
}
template <bool FULL>
__device__ __forceinline__ void tile_step8(const u32x4 (&k)[4], const u32x4 (&v)[4], const u32x2 (&qf)[2], unsigned vm, float& m2, float& l, f32x4 (&o)[4]) {
    constexpr float C = 0.125f * 1.4426950408889634f;
    f32x4 st[4];
#pragma unroll
    for (int kt = 0; kt < 4; ++kt) { f32x4 a = {0.f, 0.f, 0.f, 0.f}; a = mfma8(k[kt].x, k[kt].y, qf[0], a); a = mfma8(k[kt].z, k[kt].w, qf[1], a); st[kt] = a; }
    float mx = -1e30f;
#pragma unroll
    for (int kt = 0; kt < 4; ++kt)
#pragma unroll
        for (int j = 0; j < 4; ++j) if (FULL || ((vm >> (kt * 4 + j)) & 1u)) mx = fmaxf(mx, st[kt][j]);
    mx = fmaxf(mx, __shfl_xor(mx, 16)); mx = fmaxf(mx, __shfl_xor(mx, 32));
    const float mn2 = fmaxf(m2, mx * C); const float alpha = __builtin_amdgcn_exp2f(m2 - mn2); const float off = 8.f - mn2;
    float ps = 0.f;
#pragma unroll
    for (int kt = 0; kt < 4; ++kt)
#pragma unroll
        for (int j = 0; j < 4; ++j) { const float pv = (FULL || ((vm >> (kt * 4 + j)) & 1u)) ? __builtin_amdgcn_exp2f(__builtin_fmaf(st[kt][j], C, off)) : 0.f; st[kt][j] = pv; ps += pv; }
    l = l * alpha + ps; m2 = mn2;
#pragma unroll
    for (int dt = 0; dt < 4; ++dt) o[dt] *= alpha;
#pragma unroll
    for (int hf = 0; hf < 2; ++hf) {
        u32x2 pb; pb.x = pk4_fp8(st[2 * hf][0], st[2 * hf][1], st[2 * hf][2], st[2 * hf][3]); pb.y = pk4_fp8(st[2 * hf + 1][0], st[2 * hf + 1][1], st[2 * hf + 1][2], st[2 * hf + 1][3]);
#pragma unroll
        for (int dp = 0; dp < 2; ++dp) { o[2 * dp] = mfma8(v[hf * 2 + dp].x, v[hf * 2 + dp].y, pb, o[2 * dp]); o[2 * dp + 1] = mfma8(v[hf * 2 + dp].z, v[hf * 2 + dp].w, pb, o[2 * dp + 1]); }
    }
}
__device__ __forceinline__ void tile_step8_dup(const u32x4 (&k)[4], const u32x4 (&v)[4], const u32x2 (&qf)[2], int g, float& m2, float& l, f32x4 (&o)[4]) {
    constexpr float C = 0.125f * 1.4426950408889634f;
    f32x4 st[4];
#pragma unroll
    for (int kt = 0; kt < 4; ++kt) { f32x4 a = {0.f, 0.f, 0.f, 0.f}; a = mfma8(k[kt].x, k[kt].y, qf[0], a); a = mfma8(k[kt].z, k[kt].w, qf[1], a); st[kt] = a; }
    const bool g1 = (g & 1) != 0, g2 = (g & 2) != 0;
    float my[4];
#pragma unroll
    for (int j = 0; j < 4; ++j) { const float lo = g1 ? st[1][j] : st[0][j], hi = g1 ? st[3][j] : st[2][j]; my[j] = g2 ? hi : lo; }
    float mx = fmaxf(fmaxf(my[0], my[1]), fmaxf(my[2], my[3]));
    mx = fmaxf(mx, dpp_f(mx, 2)); mx = fmaxf(mx, dpp_f(mx, 3));
    mx = fmaxf(mx, __shfl_xor(mx, 16)); mx = fmaxf(mx, __shfl_xor(mx, 32));
    const float mn2 = fmaxf(m2, mx * C); const float alpha = __builtin_amdgcn_exp2f(m2 - mn2); const float off = 8.f - mn2;
    float ps = 0.f;
#pragma unroll
    for (int j = 0; j < 4; ++j) { my[j] = __builtin_amdgcn_exp2f(__builtin_fmaf(my[j], C, off)); ps += my[j]; }
    l = l * alpha + ps; m2 = mn2;
#pragma unroll
    for (int dt = 0; dt < 4; ++dt) o[dt] *= alpha;
    const unsigned pk = pk4_fp8(my[0], my[1], my[2], my[3]);
#pragma unroll
    for (int hf = 0; hf < 2; ++hf) {
        u32x2 pb; pb.x = (g == 2 * hf) ? pk : 0u; pb.y = (g == 2 * hf + 1) ? pk : 0u;
#pragma unroll
        for (int dp = 0; dp < 2; ++dp) { o[2 * dp] = mfma8(v[hf * 2 + dp].x, v[hf * 2 + dp].y, pb, o[2 * dp]); o[2 * dp + 1] = mfma8(v[hf * 2 + dp].z, v[hf * 2 + dp].w, pb, o[2 * dp + 1]); }
    }
}
template <class Stream>
__device__ __forceinline__ void attend_stream_dup(int ntiles, const Stream& S, const u32x2 (&qf)[2], int lane, float& m, float& l, f32x4 (&o)[4]) {
    const int g = (lane & 15) >> 2;
    u32x4 k0[4], k1[4], v0[4], v1[4];
    const bf16_t* Kp; const bf16_t* Vp;
    S.addr(0, Kp, Vp); load_tile8(Kp, Vp, lane, k0, v0);
    for (int n = 0; n < ntiles; n += 2) {
        if (n + 1 < ntiles) { S.addr(n + 1, Kp, Vp); load_tile8(Kp, Vp, lane, k1, v1); }
        tile_step8_dup(k0, v0, qf, g, m, l, o);
        if (n + 1 < ntiles) {
            if (n + 2 < ntiles) { S.addr(n + 2, Kp, Vp); load_tile8(Kp, Vp, lane, k0, v0); }
            tile_step8_dup(k1, v1, qf, g, m, l, o);
        }
    }
    l += dpp_f(l, 2); l += dpp_f(l, 3);
#pragma unroll
    for (int dt = 0; dt < 4; ++dt)
#pragma unroll
        for (int j = 0; j < 4; ++j) { float x = o[dt][j]; x += dpp_f(x, 2); x += dpp_f(x, 3); o[dt][j] = x; }
}
struct WinStream {
    const bf16_t* Kb; const bf16_t* Vb; int k00, tcol, t0;
    __device__ __forceinline__ bool full(int n) const { const int k0 = k00 + 64 * n; return (k0 + 63 <= t0) && (t0 + 3 - k0 < 512); }
    __device__ __forceinline__ void addr(int n, const bf16_t*& Kp, const bf16_t*& Vp) const { const size_t o = (size_t)((k00 >> 6) + n) * 4096; Kp = Kb + o; Vp = Vb + o; }
    __device__ __forceinline__ unsigned mask(int n, int fq) const { unsigned vm = 0u; const int k0 = k00 + 64 * n + fq * 4;
#pragma unroll
        for (int kt = 0; kt < 4; ++kt)
#pragma unroll
            for (int j = 0; j < 4; ++j) { const int df = tcol - (k0 + kt * 16 + j); if (df >= 0 && df < 512) vm |= 1u << (kt * 4 + j); }
        return vm; }
};
struct ForcedStream {
    const bf16_t* Kb; const bf16_t* Vb; int nf, cur, tcol;
    __device__ __forceinline__ int blk(int i) const { return i == 0 ? 0 : (i == nf - 1 ? cur : cur - 1); }
    __device__ __forceinline__ bool full(int n) const { return blk(n) < cur; }
    __device__ __forceinline__ void addr(int n, const bf16_t*& Kp, const bf16_t*& Vp) const { const size_t o = (size_t)blk(n) * 4096; Kp = Kb + o; Vp = Vb + o; }
    __device__ __forceinline__ unsigned mask(int n, int fq) const { unsigned vm = 0u; const int k0 = blk(n) * 64 + fq * 4;
#pragma unroll
        for (int kt = 0; kt < 4; ++kt)
#pragma unroll
            for (int j = 0; j < 4; ++j) if (k0 + kt * 16 + j <= tcol) vm |= 1u << (kt * 4 + j);
        return vm; }
};
struct SelStream {
    const bf16_t* Kb; const bf16_t* Vb; int sel, lb, t;
    __device__ __forceinline__ bool full(int) const { return true; }
    __device__ __forceinline__ void addr(int n, const bf16_t*& Kp, const bf16_t*& Vp) const { const size_t o = (size_t)__shfl(sel, lb + n) * 4096; Kp = Kb + o; Vp = Vb + o; }
    __device__ __forceinline__ unsigned mask(int n, int fq) const { unsigned vm = 0u; const int k0 = __shfl(sel, lb + n) * 64 + fq * 4;
#pragma unroll
        for (int kt = 0; kt < 4; ++kt)
#pragma unroll
            for (int j = 0; j < 4; ++j) if (k0 + kt * 16 + j <= t) vm |= 1u << (kt * 4 + j);
        return vm; }
};
template <class Stream>
__device__ __forceinline__ void attend_stream(int ntiles, const Stream& S, const u32x2 (&qf)[2], int lane, float& m, float& l, f32x4 (&o)[4]) {
    const int fq = lane >> 4;
    u32x4 k0[4], k1[4], v0[4], v1[4];
    const bf16_t* Kp; const bf16_t* Vp;
    S.addr(0, Kp, Vp); load_tile8(Kp, Vp, lane, k0, v0);
    for (int n = 0; n < ntiles; n += 2) {
        if (n + 1 < ntiles) { S.addr(n + 1, Kp, Vp); load_tile8(Kp, Vp, lane, k1, v1); }
        if (S.full(n)) tile_step8<true>(k0, v0, qf, 0u, m, l, o); else tile_step8<false>(k0, v0, qf, S.mask(n, fq), m, l, o);
        if (n + 1 < ntiles) {
            if (n + 2 < ntiles) { S.addr(n + 2, Kp, Vp); load_tile8(Kp, Vp, lane, k0, v0); }
            if (S.full(n + 1)) tile_step8<true>(k1, v1, qf, 0u, m, l, o); else tile_step8<false>(k1, v1, qf, S.mask(n + 1, fq), m, l, o);
        }
    }
}
__device__ __forceinline__ void load_q8(const bf16_t* nq, const float* rope, int bt, int head, int fq, u32x2 (&qf)[2]) {
    const bf16_t* qp = nq + (size_t)bt * 512 + head * 64 + fq * 8;
    const u32x4 q0 = *(const u32x4*)qp; const u32x4 q1 = *(const u32x4*)(qp + 32);
    u32x4 ot; ot.x = __shfl_xor(q0.x, 16); ot.y = __shfl_xor(q0.y, 16); ot.z = __shfl_xor(q0.z, 16); ot.w = __shfl_xor(q0.w, 16);
    float a[8], b[8]; unpack8(q0, a); unpack8(q1, b);
    if (fq < 2) {
        const float* tb = rope + (size_t)bt * 16; float oth[8]; unpack8(ot, oth);
        const float sg = fq == 0 ? -1.f : 1.f;
#pragma unroll
        for (int e = 0; e < 8; ++e) a[e] = a[e] * tb[e] + sg * oth[e] * tb[8 + e];
    }
    qf[0] = pk8_fp8(a); qf[1] = pk8_fp8(b);
}
template <bool ROPE>
__device__ __forceinline__ void load_q(const bf16_t* nq, const float* rope, int bt, int head, int fq, bf16x8 (&qf)[2]) {
    const bf16_t* qp = nq + (size_t)bt * 512 + head * 64 + fq * 8;
    u32x4 q0 = *(const u32x4*)qp; const u32x4 q1 = *(const u32x4*)(qp + 32);
    if (ROPE) {
        u32x4 ot; ot.x = __shfl_xor(q0.x, 16); ot.y = __shfl_xor(q0.y, 16); ot.z = __shfl_xor(q0.z, 16); ot.w = __shfl_xor(q0.w, 16);
        if (fq < 2) {
            const float* tb = rope + (size_t)bt * 16; float mine[8], oth[8], r[8]; unpack8(q0, mine); unpack8(ot, oth);
            const float sg = fq == 0 ? -1.f : 1.f;
#pragma unroll
            for (int e = 0; e < 8; ++e) r[e] = mine[e] * tb[e] + sg * oth[e] * tb[8 + e];
            q0 = pack8(r);
        }
    }
    qf[0] = __builtin_bit_cast(bf16x8, q0); qf[1] = __builtin_bit_cast(bf16x8, q1);
}
__device__ __forceinline__ void nsa_unit(const Prm& p, int unit, LAS float* impL, int lane) {
    const int fr = lane & 15, fq = lane >> 4;
    unsigned char* ws = p.ws;
    const int bg = unit >> 11, t0 = (unit & 2047) * 4, b = bg >> 1, g = bg & 1;
    const int qi = fr >> 2, hh = fr & 3, head = g * 4 + hh, tcol = t0 + qi, btcol = b * T + tcol;
    const bf16_t* nq = (const bf16_t*)(ws + WS_NQ); const float* rope = (const float*)(ws + OFF_ROPE);
    const bf16_t* kvrm = (const bf16_t*)(ws + WS_KVRM);
    float g0, g1, g2;
    { const float* gp = (const float*)(ws + WS_GATES) + (size_t)btcol * 32 + 8 + head * 3; const float* bn = p.bng + head * 3;
      g0 = sigmoidf_(gp[0] + bn[0]); g1 = sigmoidf_(gp[1] + bn[1]); g2 = sigmoidf_(gp[2] + bn[2]); }
    f32x4 tot[4];
    {
        bf16x8 qf[2]; load_q<false>(nq, rope, btcol, head, fq, qf);
        const int nc_col = tcol >= 31 ? ((tcol - 31) >> 4) + 1 : 0;
        const int nc_max = (t0 + 3) >= 31 ? ((t0 + 3 - 31) >> 4) + 1 : 0;
        const int ntl = (nc_max + 63) >> 6;
        const bf16_t* Kb = (const bf16_t*)(ws + WS_KC) + (size_t)bg * 512 * 64; const bf16_t* Vb = (const bf16_t*)(ws + WS_VCT) + (size_t)bg * 512 * 64;
        const int nc_t0 = t0 >= 31 ? ((t0 - 31) >> 4) + 1 : 0;
        float m = -1e30f, l = 0.f;
        for (int tile = 0; tile < ntl; ++tile) {
            f32x4 st[4]; st_tile_frag(Kb + (size_t)tile * 4096, qf, lane, st);
            if (tile * 64 + 63 < nc_t0) cmp_p1_tile<true>(st, tile, fq, nc_col, m, l); else cmp_p1_tile<false>(st, tile, fq, nc_col, m, l);
        }
        l += __shfl_xor(l, 16); l += __shfl_xor(l, 32);
        const float off2 = l > 0.f ? -m - __builtin_amdgcn_logf(l) : -1e30f;
        for (int j = lane; j < 1024; j += 64) impL[j] = 0.f;
        LDS_WAIT();
        f32x4 oc[4];
#pragma unroll
        for (int dt = 0; dt < 4; ++dt) oc[dt] = (f32x4){0.f, 0.f, 0.f, 0.f};
        for (int tile = 0; tile < ntl; ++tile) {
            f32x4 st[4]; st_tile_frag(Kb + (size_t)tile * 4096, qf, lane, st);
            if (tile * 64 + 63 < nc_t0) cmp_p2_tile<true>(st, tile, fq, nc_col, off2); else cmp_p2_tile<false>(st, tile, fq, nc_col, off2);
#pragma unroll
            for (int kt = 0; kt < 4; ++kt) {
                float s4 = (st[kt][0] + st[kt][1]) + (st[kt][2] + st[kt][3]); float p3 = st[kt][3];
                s4 += dpp_f(s4, 0); s4 += dpp_f(s4, 1); p3 += dpp_f(p3, 0); p3 += dpp_f(p3, 1);
                if (hh == 0) { impL[qi * 128 + tile * 16 + kt * 4 + fq] = s4; impL[512 + qi * 128 + tile * 16 + kt * 4 + fq] = p3; }
            }
            pv_tile_frag(Vb + (size_t)tile * 4096, st, lane, oc);
        }
#pragma unroll
        for (int dt = 0; dt < 4; ++dt) tot[dt] = oc[dt] * g0;
    }
    LDS_WAIT();
    int selall = 0;
    {
        const int rq = lane >> 4, c = lane & 15, tq = t0 + rq, curq = tq >> 6;
        unsigned key[8];
#pragma unroll
        for (int e = 0; e < 8; ++e) { const int j = e * 16 + c;
            const float iv = impL[rq * 128 + j] + (j > 0 ? impL[512 + rq * 128 + j - 1] : 0.f);
            const bool forced = (j == 0) || (j == curq) || (j == curq - 1), valid = j * 64 <= tq;
            const unsigned rank = forced ? 0x1FFFFFFu : (valid ? ((__builtin_bit_cast(unsigned, fmaxf(iv, 0.f)) >> 7) + 1u) : 0u);
            key[e] = (rank << 7) | (unsigned)(127 - j); }
        for (int n = 0; n < 16; ++n) {
            unsigned lm = key[0];
#pragma unroll
            for (int e = 1; e < 8; ++e) lm = lm > key[e] ? lm : key[e];
            const unsigned rm = row16_max_u32(lm);
            if (c == n) selall = 127 - (int)(rm & 127u);
#pragma unroll
            for (int e = 0; e < 8; ++e) if (key[e] == rm) key[e] = 0u;
        }
    }
    const int nf = (t0 >> 6) == 0 ? 1 : ((t0 >> 6) == 1 ? 2 : 3);
    float ms = -1e30f, ls = 0.f; f32x4 osh[4];
#pragma unroll
    for (int dt = 0; dt < 4; ++dt) osh[dt] = (f32x4){0.f, 0.f, 0.f, 0.f};
    {
        u32x2 qf[2]; load_q8(nq, rope, btcol, head, fq, qf);
        f32x4 ow[4];
#pragma unroll
        for (int dt = 0; dt < 4; ++dt) ow[dt] = (f32x4){0.f, 0.f, 0.f, 0.f};
        float m = -1e30f, l = 0.f;
        const int klo = t0 - 511 > 0 ? t0 - 511 : 0; const int tlo = klo >> 6, thi = (t0 + 3) >> 6;
        WinStream W; W.Kb = kvrm + (size_t)3 * (4 * T * 64) + (size_t)bg * T * 64; W.Vb = kvrm + (size_t)5 * (4 * T * 64) + (size_t)bg * T * 64; W.k00 = tlo * 64; W.tcol = tcol; W.t0 = t0;
        attend_stream(thi - tlo + 1, W, qf, lane, m, l, ow);
        l += __shfl_xor(l, 16); l += __shfl_xor(l, 32);
        const float sc_ = g2 / l;
#pragma unroll
        for (int dt = 0; dt < 4; ++dt) tot[dt] += ow[dt] * sc_;
        ForcedStream F_; F_.Kb = kvrm + (size_t)2 * (4 * T * 64) + (size_t)bg * T * 64; F_.Vb = kvrm + (size_t)4 * (4 * T * 64) + (size_t)bg * T * 64; F_.nf = nf; F_.cur = t0 >> 6; F_.tcol = tcol;
        attend_stream(nf, F_, qf, lane, ms, ls, osh);
    }
    {
#pragma unroll 1
        for (int r = 0; r < 4; ++r) {
            const int t = t0 + r;
            u32x2 qf[2]; load_q8(nq, rope, b * T + t, head, fq, qf);
            f32x4 os[4];
#pragma unroll
            for (int dt = 0; dt < 4; ++dt) os[dt] = (f32x4){0.f, 0.f, 0.f, 0.f};
            float m = -1e30f, l = 0.f;
            SelStream S_; S_.Kb = kvrm + (size_t)2 * (4 * T * 64) + (size_t)bg * T * 64; S_.Vb = kvrm + (size_t)4 * (4 * T * 64) + (size_t)bg * T * 64; S_.sel = selall; S_.lb = r * 16 + nf; S_.t = t;
            const int nv = (t >> 6) + 1 < 16 ? (t >> 6) + 1 : 16;
            if (nv > nf) {
                attend_stream_dup(nv - nf, S_, qf, lane, m, l, os);
                if (qi == r) {
                    const float mn = fmaxf(ms, m), a1 = __builtin_amdgcn_exp2f(ms - mn), a2 = __builtin_amdgcn_exp2f(m - mn);
                    ls = ls * a1 + l * a2; ms = mn;
#pragma unroll
                    for (int dt = 0; dt < 4; ++dt) osh[dt] = osh[dt] * a1 + os[dt] * a2;
                }
            }
        }
        ls += __shfl_xor(ls, 16); ls += __shfl_xor(ls, 32);
        const float scs = g1 / ls;
#pragma unroll
        for (int dt = 0; dt < 4; ++dt) tot[dt] += osh[dt] * scs;
    }
    bf16_t* yn = (bf16_t*)(ws + WS_YN) + (size_t)btcol * 512 + head * 64 + fq * 4;
#pragma unroll
    for (int dt = 0; dt < 4; ++dt) { u32x2 o; o.x = pk2(tot[dt][0], tot[dt][1]); o.y = pk2(tot[dt][2], tot[dt][3]); *(u32x2*)(yn + dt * 16) = o; }
}
__device__ __forceinline__ void phaseC3(const Prm& p, LAS unsigned char* L, int G) {
    const int tid = threadIdx.x, lane = tid & 63, wave = tid >> 6;
    unsigned char* ws = p.ws;
    if (((int)blockIdx.x & 3) == 0 && ((int)blockIdx.x >> 2) < NBM) mlstm_scan(p, L);
    if ((int)blockIdx.x == 1) {
        const int bh = wave; const float* kn = (const float*)(ws + WS_KN); float* np = (float*)(ws + WS_NPREV); const float* dec = (const float*)(ws + OFF_DEC);
        f32x4 n = {0.f, 0.f, 0.f, 0.f};
        for (int c = 0; c < 128; ++c) { const size_t u = (size_t)bh * 128 + c;
            *(f32x4*)(np + u * 256 + lane * 4) = n; const f32x4 k = *(const f32x4*)(kn + u * 256 + lane * 4); n = n * dec[u] + k; }
    }
    LAS float* impL = (LAS float*)(L + wave * 4096);
    unsigned* ctr = (unsigned*)(ws + OFF_CTR);
    const int x0 = (int)blockIdx.x & 7;
    for (int dx = 0; dx < 8; ++dx) {
        const int x = (x0 + dx) & 7;
        for (;;) {
            unsigned u = 0u; if (lane == 0) u = atomicAdd(ctr + x * 8, 1u);
            u = (unsigned)__shfl((int)u, 0);
            if (u >= 1024u) break;
            nsa_unit(p, (x >> 1) * 2048 + 2 * (1023 - (int)u) + (x & 1), impL, lane);
        }
    }
}

__device__ __forceinline__ void phaseC4(const Prm& p, int G) {
    const int tid = threadIdx.x, lane = tid & 63, wave = tid >> 6;
    unsigned char* ws = p.ws;
    const bf16_t* Qt = (const bf16_t*)p.out; bf16_t* NUM = (bf16_t*)(ws + WS_NUM);
    const float* np = (const float*)(ws + WS_NPREV); const float* rs = (const float*)(ws + OFF_RS); const float* mtv = (const float*)(ws + OFF_MT);
    for (int u = blockIdx.x; u < 1024; u += G) {
        const int bh = u >> 7, c = u & 127, b = bh >> 2, h = bh & 3;
        const f32x4 n4 = *(const f32x4*)(np + (size_t)u * 256 + lane * 4); const f32x4 g4 = *(const f32x4*)(p.mhg + h * 256 + lane * 4);
#pragma unroll
        for (int rr = 0; rr < 8; ++rr) {
            const int l = wave * 8 + rr; const size_t row = (size_t)b * T + c * 64 + l; const int si = bh * T + c * 64 + l;
            const u32x2 qw = *(const u32x2*)(Qt + row * 1024 + h * 256 + lane * 4);
            const float dot = wave_sum((bflo(qw.x) * n4[0] + bfhi(qw.x) * n4[1]) + (bflo(qw.y) * n4[2] + bfhi(qw.y) * n4[3]));
            const float den = dot + rs[si]; const float dd = fmaxf(fabsf(den), __expf(-mtv[si])); const float idd = 1.f / dd;
            bf16_t* npnt = NUM + row * 1024 + h * 256 + lane * 4; const u32x2 nw = *(const u32x2*)npnt;
            const float h0 = bflo(nw.x) * idd, h1 = bfhi(nw.x) * idd, h2 = bflo(nw.y) * idd, h3 = bfhi(nw.y) * idd;
            const float mu = wave_sum((h0 + h1) + (h2 + h3)) * (1.f / 256.f);
            const float d0 = h0 - mu, d1 = h1 - mu, d2 = h2 - mu, d3 = h3 - mu;
            const float var = wave_sum((d0 * d0 + d1 * d1) + (d2 * d2 + d3 * d3)) * (1.f / 256.f);
            const float rsd = 1.f / sqrtf(var + EPS);
            u32x2 o; o.x = pk2(d0 * rsd * g4[0], d1 * rsd * g4[1]); o.y = pk2(d2 * rsd * g4[2], d3 * rsd * g4[3]);
            *(u32x2*)npnt = o;
        }
    }
}
__device__ __forceinline__ void phaseG(const Prm& p, int G) {
    const int tid = threadIdx.x, lane = tid & 63, wave = tid >> 6; const int gw = blockIdx.x * NWAVES + wave, NGW = G * NWAVES;
    const float* rowss = (const float*)(p.ws + OFF_RSS16);
#pragma unroll 4
    for (int m = gw; m < M; m += NGW) {
        float ssum = 0.f;
#pragma unroll
        for (int k = 0; k < 16; ++k) ssum += rowss[(size_t)m * 16 + k];
        const float r = 1.f / sqrtf(ssum * (1.f / D) + EPS);
        f32x4* o = (f32x4*)(p.out + (size_t)m * D) + lane; const f32x4* gr = (const f32x4*)p.fng + lane;
#pragma unroll
        for (int j = 0; j < 4; ++j) { const f32x4 v = o[64 * j], g = gr[64 * j]; o[64 * j] = (f32x4){v[0] * r * g[0], v[1] * r * g[1], v[2] * r * g[2], v[3] * r * g[3]}; }
    }
}

#define XB_TMO      128
#define XB_XCNT(j)  (256  + 64 * (j))
#define XB_XSUB(j)  (1280 + 64 * (j))
#define XB_XGEN(j)  (2304 + 64 * (j))
#define XB_TOP      3328
#define XB_TOPGEN   3392
#define XCD_BAR_WORDS 3456
#define XB_SPIN_CAP (1u << 18)

__device__ __forceinline__ unsigned xb_ld(unsigned* p)              { return __hip_atomic_load(p, __ATOMIC_RELAXED, __HIP_MEMORY_SCOPE_AGENT); }
__device__ __forceinline__ unsigned xb_add(unsigned* p, unsigned v) { return __hip_atomic_fetch_add(p, v, __ATOMIC_RELAXED, __HIP_MEMORY_SCOPE_AGENT); }
__device__ __forceinline__ unsigned xb_xcc_id() { return (unsigned)__builtin_amdgcn_s_getreg((3 << 11) | 20) & 0xFu; }
#define XB_SPIN(cond, bar) do { unsigned _sp = 0; while (cond) { __builtin_amdgcn_s_sleep(1); \
    if ((++_sp & 255u) == 0u) { if (xb_ld(&(bar)[XB_TMO])) break; if (_sp > XB_SPIN_CAP) { atomicAdd(&(bar)[XB_TMO], 1u); break; } } } } while (0)

struct XcdBarrier {
    unsigned* bar; unsigned x;
    volatile LAS unsigned* st;
};

__device__ __forceinline__ XcdBarrier xcd_barrier_post(unsigned* bar, volatile LAS unsigned* st) {
    XcdBarrier b; b.bar = bar; b.x = xb_xcc_id(); b.st = st;
    if (threadIdx.x == 0) (void)xb_add(&bar[XB_XCNT(b.x)], 1u);
    return b;
}
__device__ __forceinline__ void xcd_barrier_complete(unsigned* bar, unsigned x, unsigned& nloc, unsigned& nx) {
    const unsigned G = gridDim.x * gridDim.y * gridDim.z;
    unsigned sum, cnt, mine, sp = 0u;
    for (;;) {
        sum = 0u; cnt = 0u; mine = 0u;
#pragma unroll
        for (unsigned j = 0; j < 16; ++j) { const unsigned c = xb_ld(&bar[XB_XCNT(j)]); sum += c; cnt += (c > 0u) ? 1u : 0u; mine = (j == x) ? c : mine; }
        if (sum == G) break;
        __builtin_amdgcn_s_sleep(1);
        if ((++sp & 255u) == 0u) { if (xb_ld(&bar[XB_TMO])) break; if (sp > XB_SPIN_CAP) { atomicAdd(&bar[XB_TMO], 1u); break; } }
    }
    nloc = mine > 0u ? mine : 1u; nx = cnt > 0u ? cnt : 1u;
}

__device__ __forceinline__ void xcd_barrier(const XcdBarrier& b) {
    asm volatile("s_waitcnt vmcnt(0)" ::: "memory");
    __syncthreads();
    if (threadIdx.x == 0) {
        unsigned* bar = b.bar;
        __builtin_amdgcn_s_waitcnt(0);
        unsigned nloc = b.st[0], nx = b.st[1];
        if (nloc == 0u) { xcd_barrier_complete(bar, b.x, nloc, nx); b.st[0] = nloc; b.st[1] = nx; }
        const unsigned old = xb_add(&bar[XB_XSUB(b.x)], 1u);
        const unsigned gen = old / nloc;
        if (old + 1u == (gen + 1u) * nloc) {
            __builtin_amdgcn_fence(__ATOMIC_RELEASE, "agent");
            asm volatile("s_waitcnt vmcnt(0)" ::: "memory");
            const unsigned og = xb_add(&bar[XB_TOP], 1u);
            const unsigned tg = og / nx;
            if (og + 1u == (tg + 1u) * nx) xb_add(&bar[XB_TOPGEN], 1u);
            else XB_SPIN(xb_ld(&bar[XB_TOPGEN]) == tg, bar);
            __builtin_amdgcn_fence(__ATOMIC_ACQUIRE, "agent");
            xb_add(&bar[XB_XGEN(b.x)], 1u);
            asm volatile("s_waitcnt vmcnt(0)" ::: "memory");
        } else {
            XB_SPIN(xb_ld(&bar[XB_XGEN(b.x)]) == gen, bar);
            __builtin_amdgcn_fence(__ATOMIC_ACQUIRE, "agent");
            asm volatile("s_waitcnt vmcnt(0)" ::: "memory");
        }
    }
    __syncthreads();
}

constexpr int N_PHASES = 11;
__global__ void __launch_bounds__(NTHR, 2) fwd_kernel(Prm p) {
    extern __shared__ __attribute__((aligned(16))) unsigned char lds[];
    LAS unsigned char* L = (LAS unsigned char*)lds;
    const int G = gridDim.x;
    unsigned char* ws = p.ws;
    const int lo = p.ph_lo, hi = p.ph_hi;
    volatile LAS unsigned* bst = (volatile LAS unsigned*)(L + 135168);
    if (threadIdx.x < 2) bst[threadIdx.x] = 0u;
    __syncthreads();
    XcdBarrier bar; bar.bar = (unsigned*)(ws + OFF_BAR); bar.x = 0; bar.st = nullptr;
    if (p.coop) bar = xcd_barrier_post((unsigned*)(ws + OFF_BAR), bst);
#define IN(k) (lo <= (k) && (k) < hi)
#define SEAM(k) do { if (p.coop && IN((k) + 1)) { xcd_barrier(bar); } } while (0)
    if (IN(0)) { phaseA(p, L, G); SEAM(0); }
    if (IN(1)) {
        pg8::Gemm g{(const bf16_t*)(ws + WS_XN), (const bf16_t*)(ws + WS_WIN), M, N1, D}; pg8::StaticOrder S; S.init(M, N1, G, (int)blockIdx.x);
        EpiP1 E{(bf16_t*)(ws + WS_MQ), (bf16_t*)(ws + WS_NQ), (bf16_t*)(ws + WS_KVRM), (bf16_t*)(ws + WS_VT), (float*)(ws + WS_GATES)};
        pg8::gemm_phase<EpiP1, pg8::StaticOrder, true, true>(L, g, S, E);
        deferred_weights(p, L, G);
        SEAM(1);
    }
    if (IN(2)) { phaseC1(p, L, G); SEAM(2); }
    if (IN(3)) { phaseC2(p, L, G); SEAM(3); }
    if (IN(4)) { phaseC3(p, L, G); SEAM(4); }
    if (IN(5)) { phaseC4(p, G); SEAM(5); }
    if (IN(6)) {
        pg8::Gemm g{(const bf16_t*)(ws + WS_XN), (const bf16_t*)(ws + WS_WIN) + (size_t)N1 * D, M, N2, D}; pg8::StaticOrder S; S.init(M, N2, G, (int)blockIdx.x);
        EpiP2 E{(bf16_t*)(ws + WS_NUM), (bf16_t*)(ws + WS_YN), (bf16_t*)(ws + WS_MQ), (bf16_t*)(ws + WS_MK)};
        pg8::gemm_phase<EpiP2, pg8::StaticOrder, true, true>(L, g, S, E);
        SEAM(6);
    }
    if (IN(7)) {
        pg8::Gemm g{(const bf16_t*)(ws + WS_NUM), (const bf16_t*)(ws + WS_WA), M, D, D}; pg8::StaticOrder S; S.init(M, D, G, (int)blockIdx.x);
        EpiE1 E{(const bf16_t*)(ws + WS_MQ), (bf16_t*)p.out};
        pg8::gemm_phase<EpiE1, pg8::StaticOrder, true, true>(L, g, S, E);
    }
    if (IN(8)) {
        pg8::Gemm g{(const bf16_t*)(ws + WS_YN), (const bf16_t*)(ws + WS_WB), M, D, 512}; pg8::StaticOrder S; S.init(M, D, G, (int)blockIdx.x);
        EpiE2 E{(const bf16_t*)(ws + WS_MK), (const bf16_t*)p.out, (bf16_t*)(ws + WS_XN)};
        pg8::gemm_phase<EpiE2, pg8::StaticOrder, true, true>(L, g, S, E);
        SEAM(8);
    }
    if (IN(9)) {
        pg8::Gemm g{(const bf16_t*)(ws + WS_XN), (const bf16_t*)(ws + WS_WO), M, D, D}; pg8::StaticOrder S; S.init(M, D, G, (int)blockIdx.x);
        EpiFN E{p.x, p.out, p.fng, (float*)(ws + OFF_RSS16), (unsigned*)(ws + OFF_BAR + 14 * KiB)};
        pg8::gemm_phase<EpiFN, pg8::StaticOrder, false, true>(L, g, S, E);
    }
#undef IN
#undef SEAM
}

#ifndef MK_COOP
#define MK_COOP 1
#endif
extern "C" void kernel_launch(void* const* d_in, const int* in_sizes, int n_in, void* d_out, int out_size, void* d_ws, size_t ws_size, hipStream_t stream) {
    static int grid = 0;
    if (grid == 0) {
        int dev = 0, cus = 0, per_cu = 0;
        if (n_in != 22 || ws_size < WS_END) { fprintf(stderr, "kernel_launch: unexpected n_in %d / ws %zu\n", n_in, ws_size); grid = -1; return; }
        (void)hipGetDevice(&dev); (void)hipDeviceGetAttribute(&cus, hipDeviceAttributeMultiprocessorCount, dev);
        if (hipFuncSetAttribute((const void*)fwd_kernel, hipFuncAttributeMaxDynamicSharedMemorySize, LDS_BYTES) != hipSuccess) { fprintf(stderr, "kernel_launch: hipFuncSetAttribute failed\n"); grid = -1; return; }
        if (hipOccupancyMaxActiveBlocksPerMultiprocessor(&per_cu, (const void*)fwd_kernel, NTHR, LDS_BYTES) != hipSuccess || per_cu < 1) { fprintf(stderr, "kernel_launch: occupancy query gave %d\n", per_cu); per_cu = 1; }
        (void)hipGetLastError();
        grid = cus * (per_cu > 1 ? 1 : per_cu);
        if (grid < NBM * 4) { fprintf(stderr, "kernel_launch: grid %d too small\n", grid); grid = -1; return; }
    }
    if (grid < 0) return;
    Prm p{};
    p.x = (const float*)d_in[0]; p.pos = (const int*)d_in[1]; p.norm_g = (const float*)d_in[2]; p.w_in = (const float*)d_in[3];
    p.cqw = (const float*)d_in[4]; p.cqb = (const float*)d_in[5]; p.ckw = (const float*)d_in[6]; p.ckb = (const float*)d_in[7];
    p.big = (const float*)d_in[8]; p.bfg = (const float*)d_in[9]; p.mhg = (const float*)d_in[10];
    p.cpk = (const float*)d_in[11]; p.cw1k = (const float*)d_in[12]; p.cw2k = (const float*)d_in[13];
    p.cpv = (const float*)d_in[14]; p.cw1v = (const float*)d_in[15]; p.cw2v = (const float*)d_in[16];
    p.bng = (const float*)d_in[17]; p.wa = (const float*)d_in[18]; p.wb = (const float*)d_in[19]; p.wo = (const float*)d_in[20]; p.fng = (const float*)d_in[21];
    p.out = (float*)d_out; p.ws = (unsigned char*)d_ws;
#if MK_COOP
    (void)hipMemsetAsync((char*)d_ws + OFF_BAR, 0, 16 * KiB, stream);
    p.ph_lo = 0; p.ph_hi = N_PHASES; p.coop = 1; p.pad = 0;
    void* args[] = {&p};
    hipError_t e = hipLaunchCooperativeKernel((const void*)fwd_kernel, dim3(grid), dim3(NTHR), args, LDS_BYTES, stream);
    if (e != hipSuccess) fprintf(stderr, "kernel_launch: cooperative launch failed: %s (grid %d)\n", hipGetErrorString(e), grid);
#else
    for (int ph = 0; ph < N_PHASES; ++ph) {
        p.ph_lo = ph; p.ph_hi = ph + 1; p.coop = 0; p.pad = 0;
        hipLaunchKernelGGL(fwd_kernel, dim3(grid), dim3(NTHR), LDS_BYTES, stream, p);
    }
#endif
}
```
